# Optimizing an MI355X kernel written in HIP

```python
import math
import jax, jax.numpy as jnp
from jax import lax
import numpy as np

D_MODEL = 2048
BATCH = 1
SEQ = 16384
DEPTH = 2

N_A_LAYERS = DEPTH // 2
N_B_LAYERS = DEPTH - N_A_LAYERS
BLK = 128
ROPE_THETA = 500000.0
NORM_EPS = 1e-6

A_HEAD_DIM = 128
A_HEADS = D_MODEL // A_HEAD_DIM
A_ROT_DIM = A_HEAD_DIM // 4
A_GROUPS = ((128, 1), (512, 4), (2048, 16))
N_A_GROUPS = len(A_GROUPS)
A_GROUP_WIDTH = A_HEADS * A_HEAD_DIM

B_HEADS = D_MODEL // 128
B_NOPE_DIM = 128
B_ROPE_DIM = 64
B_V_DIM = 128
B_Q_LORA = 512
B_KV_LORA = 512

FFN_HIDDEN = -(-(8 * D_MODEL) // (3 * 256)) * 256

kernel_name = 'yoco_dilated_mla_hybrid'


def rms_norm(x, g):
    x32 = x.astype(jnp.float32)
    y = x32 * lax.rsqrt(jnp.mean(x32 * x32, axis=-1, keepdims=True) + NORM_EPS)
    return (y * g.astype(jnp.float32)).astype(x.dtype)


def rope_angles(seq_len, dim):
    inv_freq = ROPE_THETA ** (-jnp.arange(0, dim, 2, dtype=jnp.float32) / dim)
    ang = jnp.arange(seq_len, dtype=jnp.float32)[:, None] * inv_freq[None, :]
    return jnp.cos(ang), jnp.sin(ang)


def apply_rope(x, cos, sin):
    half = x.shape[-1] // 2
    x32 = x.astype(jnp.float32)
    x1, x2 = x32[..., :half], x32[..., half:]
    c = cos[None, :, None, :]
    s = sin[None, :, None, :]
    return jnp.concatenate([x1 * c - x2 * s, x2 * c + x1 * s], axis=-1).astype(x.dtype)


def partial_rope(x, cos, sin):
    return jnp.concatenate([apply_rope(x[..., :A_ROT_DIM], cos, sin), x[..., A_ROT_DIM:]], axis=-1)


def dilated_window_branch(q, k, v, window, dilation):
    b, s, h, e = q.shape
    span = window // dilation
    n_prev = -(-span // BLK)
    chunk = dilation * BLK
    sp = -(-s // chunk) * chunk
    m = sp // dilation
    nb = m // BLK

    def to_blocks(t):
        t = jnp.pad(t, ((0, 0), (0, sp - s), (0, 0), (0, 0)))
        t = t.reshape(b, m, dilation, h, e).transpose(0, 2, 1, 3, 4)
        return t.reshape(b, dilation, nb, BLK, h, e)

    def band(t):
        tp = jnp.pad(t, ((0, 0), (0, 0), (n_prev, 0), (0, 0), (0, 0), (0, 0)))
        return jnp.concatenate([tp[:, :, j:j + nb] for j in range(n_prev + 1)], axis=3)

    qb = to_blocks(q)
    kband = band(to_blocks(k))
    vband = band(to_blocks(v))
    kb_len = (n_prev + 1) * BLK
    qi = jnp.arange(BLK)[:, None]
    kj = jnp.arange(kb_len)[None, :]
    dist = qi + n_prev * BLK - kj
    key_sub = (jnp.arange(nb)[:, None, None] - n_prev) * BLK + kj[None]
    valid = (dist >= 0)[None] & (dist <= span)[None] & (key_sub >= 0)

    scale = e ** -0.5
    sc = jnp.einsum('bdnqhe,bdnkhe->bdnhqk', qb, kband, preferred_element_type=jnp.float32) * scale
    sc = jnp.where(valid[None, None, :, None], sc, -jnp.inf)
    lse = jax.nn.logsumexp(sc, axis=-1)
    p = jnp.exp(sc - lse[..., None])
    out = jnp.einsum('bdnhqk,bdnkhe->bdnqhe', p.astype(v.dtype), vband, preferred_element_type=jnp.float32)
    out = out.reshape(b, dilation, m, h, e).transpose(0, 2, 1, 3, 4).reshape(b, sp, h, e)[:, :s]
    lse = lse.transpose(0, 1, 2, 4, 3).reshape(b, dilation, m, h).transpose(0, 2, 1, 3).reshape(b, sp, h)[:, :s]
    return out, lse


def dilated_attention(xn, w_qkv, w_o, cos, sin):
    b, s, _ = xn.shape
    qkv = (xn @ w_qkv).reshape(b, s, N_A_GROUPS, 3, A_HEADS, A_HEAD_DIM)
    outs, lses = [], []
    for g, (window, dilation) in enumerate(A_GROUPS):
        q = partial_rope(qkv[:, :, g, 0], cos, sin)
        k = partial_rope(qkv[:, :, g, 1], cos, sin)
        o, l = dilated_window_branch(q, k, qkv[:, :, g, 2], window, dilation)
        outs.append(o)
        lses.append(l)
    wts = jax.nn.softmax(jnp.stack(lses), axis=0)
    o = jnp.sum(wts[..., None] * jnp.stack(outs), axis=0)
    return o.astype(xn.dtype).reshape(b, s, A_GROUP_WIDTH) @ w_o


def mla_shared_kv(h, kv_norm_g, w_kv_a, kv_a_norm_g, w_kv_b, cos, sin):
    b, s, _ = h.shape
    ckv = rms_norm(h, kv_norm_g) @ w_kv_a
    c = rms_norm(ckv[..., :B_KV_LORA], kv_a_norm_g)
    k_pe = apply_rope(ckv[..., None, B_KV_LORA:], cos, sin)[:, :, 0]
    kv = (c @ w_kv_b).reshape(b, s, B_HEADS, B_NOPE_DIM + B_V_DIM)
    return kv[..., :B_NOPE_DIM], k_pe, kv[..., B_NOPE_DIM:]


def mla_attention(xn, k_nope, k_pe, v, w_q_a, q_a_norm_g, w_q_b, w_o, cos, sin):
    b, s, _ = xn.shape
    cq = rms_norm(xn @ w_q_a, q_a_norm_g)
    q = (cq @ w_q_b).reshape(b, s, B_HEADS, B_NOPE_DIM + B_ROPE_DIM)
    q_nope = q[..., :B_NOPE_DIM]
    q_pe = apply_rope(q[..., B_NOPE_DIM:], cos, sin)
    nb = s // BLK
    scale = (B_NOPE_DIM + B_ROPE_DIM) ** -0.5
    key_pos = jnp.arange(s)

    def to_blocks(t):
        return t.reshape(b, nb, BLK, *t.shape[2:]).swapaxes(0, 1)

    def block_attn(args):
        qn, qp, i = args
        sc = (jnp.einsum('bqhe,bkhe->bhqk', qn, k_nope, preferred_element_type=jnp.float32)
              + jnp.einsum('bqhr,bkr->bhqk', qp, k_pe, preferred_element_type=jnp.float32)) * scale
        q_pos = i * BLK + jnp.arange(BLK)
        sc = jnp.where(key_pos[None, :] <= q_pos[:, None], sc, -jnp.inf)
        p = jax.nn.softmax(sc, axis=-1)
        return jnp.einsum('bhqk,bkhe->bqhe', p.astype(v.dtype), v, preferred_element_type=jnp.float32).astype(v.dtype)

    o = lax.map(block_attn, (to_blocks(q_nope), to_blocks(q_pe), jnp.arange(nb)))
    o = o.swapaxes(0, 1).reshape(b, s, B_HEADS * B_V_DIM)
    return o @ w_o


def swiglu(xn, w_gu, w_down):
    g, u = jnp.split(xn @ w_gu, 2, axis=-1)
    return (jax.nn.silu(g) * u) @ w_down


def setup_inputs(seed: int = 0) -> dict:
    key = jax.random.key(seed)
    ks = jax.random.split(key, 16)

    def w(k, shape, fan_in):
        return jax.random.normal(k, shape, jnp.float32) * fan_in ** -0.5

    def gain(k, shape):
        return 1.0 + 0.02 * jax.random.normal(k, shape, jnp.float32)

    a_cols = N_A_GROUPS * 3 * A_GROUP_WIDTH
    return {
        'x': jax.random.normal(ks[0], (BATCH, SEQ, D_MODEL), jnp.float32),
        'attn_norm_g': gain(ks[1], (DEPTH, D_MODEL)),
        'ffn_norm_g': gain(ks[2], (DEPTH, D_MODEL)),
        'a_w_qkv': w(ks[3], (N_A_LAYERS, D_MODEL, a_cols), D_MODEL),
        'a_w_o': w(ks[4], (N_A_LAYERS, A_GROUP_WIDTH, D_MODEL), A_GROUP_WIDTH),
        'kv_norm_g': gain(ks[5], (D_MODEL,)),
        'b_w_kv_a': w(ks[6], (D_MODEL, B_KV_LORA + B_ROPE_DIM), D_MODEL),
        'b_kv_a_norm_g': gain(ks[7], (B_KV_LORA,)),
        'b_w_kv_b': w(ks[8], (B_KV_LORA, B_HEADS * (B_NOPE_DIM + B_V_DIM)), B_KV_LORA),
        'b_w_q_a': w(ks[9], (N_B_LAYERS, D_MODEL, B_Q_LORA), D_MODEL),
        'b_q_a_norm_g': gain(ks[10], (N_B_LAYERS, B_Q_LORA)),
        'b_w_q_b': w(ks[11], (N_B_LAYERS, B_Q_LORA, B_HEADS * (B_NOPE_DIM + B_ROPE_DIM)), B_Q_LORA),
        'b_w_o': w(ks[12], (N_B_LAYERS, B_HEADS * B_V_DIM, D_MODEL), B_HEADS * B_V_DIM),
        'ffn_w_gu': w(ks[13], (DEPTH, D_MODEL, 2 * FFN_HIDDEN), D_MODEL),
        'ffn_w_down': w(ks[14], (DEPTH, FFN_HIDDEN, D_MODEL), FFN_HIDDEN),
        'final_norm_g': gain(ks[15], (D_MODEL,)),
    }


def reference(x, attn_norm_g, ffn_norm_g, a_w_qkv, a_w_o, kv_norm_g, b_w_kv_a, b_kv_a_norm_g, b_w_kv_b,
              b_w_q_a, b_q_a_norm_g, b_w_q_b, b_w_o, ffn_w_gu, ffn_w_down, final_norm_g):
    s = x.shape[1]
    cos_a, sin_a = rope_angles(s, A_ROT_DIM)
    cos_b, sin_b = rope_angles(s, B_ROPE_DIM)
    h = x
    k_nope = k_pe = v_shared = None
    for layer in range(DEPTH):
        if layer == N_A_LAYERS:
            k_nope, k_pe, v_shared = mla_shared_kv(h, kv_norm_g, b_w_kv_a, b_kv_a_norm_g, b_w_kv_b, cos_b, sin_b)
        xn = rms_norm(h, attn_norm_g[layer])
        if layer < N_A_LAYERS:
            h = h + dilated_attention(xn, a_w_qkv[layer], a_w_o[layer], cos_a, sin_a)
        else:
            j = layer - N_A_LAYERS
            h = h + mla_attention(xn, k_nope, k_pe, v_shared, b_w_q_a[j], b_q_a_norm_g[j], b_w_q_b[j], b_w_o[j], cos_b, sin_b)
        h = h + swiglu(rms_norm(h, ffn_norm_g[layer]), ffn_w_gu[layer], ffn_w_down[layer])
    return rms_norm(h, final_norm_g)
```

```cpp
#include <hip/hip_runtime.h>
#include <hip/hip_cooperative_groups.h>
#include <cstdio>
#include <cstdint>
#include <cmath>
namespace cg = cooperative_groups;
__device__ __forceinline__ int mk_lane() { unsigned z = 0u; asm volatile("" : "+s"(z)); return (int)__builtin_amdgcn_mbcnt_hi(~0u, __builtin_amdgcn_mbcnt_lo(~0u, z)); }
namespace pg8 {
#define PG8_LAS __attribute__((address_space(3)))
typedef unsigned short bf16_t;
typedef short bf16x8 __attribute__((ext_vector_type(8)));
typedef float f32x4 __attribute__((ext_vector_type(4)));
typedef unsigned u32x4 __attribute__((ext_vector_type(4)));
constexpr int BM = 256, BK = 64, HALF = 128, HTB = HALF * BK * 2  , STAGE_BYTES = 8 * HTB, NXCD = 8, WGM = 8;

__host__ __device__ __forceinline__ int lds_byte(int r, int c) { const int st = (r >> 4) * 2 + (c >> 5), rr = r & 15, cc = c & 31, ob = rr * 64 + cc * 2; return st * 1024 + (ob ^ (((ob >> 9) & 1) << 5)); }
__host__ __device__ __forceinline__ void stage_rc(int b, int& R, int& C) { const int st = b / 1024, sb = b % 1024, swz = sb ^ (((sb >> 9) & 1) << 5); R = (st >> 1) * 16 + swz / 64; C = (st & 1) * 32 + (swz % 64) / 2; }
__host__ __device__ __forceinline__ int perm32(int rho) { const int n = rho >> 4, i = rho & 15; return 8 * (i >> 2) + 4 * n + (i & 3); }

struct Unit { int pm, pn; };
struct Gemm { const bf16_t* A; const bf16_t* Bt; int M, N, K; };

struct StaticOrder {
    int nM, nN, nwg, G, c;
    __host__ __device__ void init(int M, int N, int G_, int c_) { nM = M / BM; nN = N / BM; nwg = nM * nN; G = G_; c = c_; }
    __host__ __device__ bool next(int i, Unit& u) const {
        const long L = (long)i * G + c; if (L >= nwg) return false;
        int wgid = (int)L; { const int q = nwg / NXCD, r = nwg % NXCD, xcd = wgid % NXCD, off = wgid / NXCD; wgid = (xcd < r ? xcd * (q + 1) : r * (q + 1) + (xcd - r) * q) + off; }
        const int nig = WGM * nN, gid = wgid / nig, fm = gid * WGM, gsz = (nM - fm) < WGM ? (nM - fm) : WGM;
        u.pm = fm + ((wgid % nig) % gsz); u.pn = (wgid % nig) / gsz; return true;
    }
    __device__ __forceinline__ void a_ready(const Unit&) const {}
    __device__ __forceinline__ void done(const Unit&) const {}
};
__device__ __forceinline__ unsigned cvt_pk_bf16(float lo, float hi) { unsigned r; asm volatile("v_cvt_pk_bf16_f32 %0, %1, %2" : "=v"(r) : "v"(lo), "v"(hi)); return r; }
typedef float f32x2 __attribute__((ext_vector_type(2)));
template <class Epi, class Sched, bool ALIGN_EPI = false, bool SP2 = false>
__device__ __forceinline__ void gemm_phase(PG8_LAS unsigned char* lds, const Gemm g, const Sched& S, const Epi& E, const int wave_) {
    int tid_ = wave_ * 64 + mk_lane(); asm volatile("" : "+v"(tid_));
    const int tid = tid_, wid = __builtin_amdgcn_readfirstlane(tid >> 6), lane = tid & 63, wr = wid >> 2, wc = wid & 3, fr = lane & 15, fq = lane >> 4;
    const int K = g.K, nt = K / BK;
    unsigned voffA[2], voffB[2];
#pragma unroll
    for (int i = 0; i < 2; ++i) { int R, C; stage_rc(tid * 16 + i * 8192, R, C); const int Rb = Epi::PERM ? ((R & ~31) + perm32(R & 31)) : R;
        voffA[i] = (unsigned)(R * K + C) * 2u; voffB[i] = (unsigned)(Rb * K + C) * 2u; }
    const size_t kstep = (size_t)(BK * 2);
    const size_t hstep = (size_t)HALF * K * 2;
    const size_t tstep = 2 * hstep;
    const unsigned ldsw = (unsigned)wid * 1024u;
    const int aoff = lds_byte(wr * 64 + fr, fq * 8), boff = lds_byte(wc * 32 + fr, fq * 8);
#define PG8_SA(b, h) (((b) * 2 + (h)) * HTB)
#define PG8_SB(b, h) ((4 + (b) * 2 + (h)) * HTB)
#define PG8_STAGE(bufoff, gbase, voff) do { _Pragma("unroll") for (int _i = 0; _i < 2; ++_i) \
        __builtin_amdgcn_global_load_lds((const unsigned*)((const char*)(gbase) + (voff)[_i]), (PG8_LAS unsigned*)(lds + (bufoff) + ldsw + _i * 8192), 16, 0, 0); } while (0)
#define PG8_LDA(dst, b, h) do { _Pragma("unroll") for (int m = 0; m < 4; ++m) _Pragma("unroll") for (int k = 0; k < 2; ++k) dst[m][k] = *(const PG8_LAS bf16x8*)(lds + PG8_SA(b, h) + aoff + m * 2048 + k * 1024); } while (0)
#define PG8_LDB(dst, b, h) do { _Pragma("unroll") for (int n = 0; n < 2; ++n) _Pragma("unroll") for (int k = 0; k < 2; ++k) dst[n][k] = *(const PG8_LAS bf16x8*)(lds + PG8_SB(b, h) + boff + n * 2048 + k * 1024); } while (0)
#define PG8_MMA(ai, bj, At, Bt) do { __builtin_amdgcn_s_setprio(1); _Pragma("unroll") for (int m = 0; m < 4; ++m) _Pragma("unroll") for (int n = 0; n < 2; ++n) _Pragma("unroll") for (int k = 0; k < 2; ++k) \
        acc[ai][bj][m][n] = __builtin_amdgcn_mfma_f32_16x16x32_bf16(Bt[n][k], At[m][k], acc[ai][bj][m][n], 0, 0, 0); __builtin_amdgcn_s_setprio(0); } while (0)
#define PG8_WAIT_V(n) asm volatile("s_waitcnt vmcnt(" #n ")" ::: "memory")
#define PG8_WAIT_L(n) asm volatile("s_waitcnt lgkmcnt(" #n ")" ::: "memory")
#define PG8_BAR __builtin_amdgcn_s_barrier()
#define PG8_SCHED __builtin_amdgcn_sched_barrier(0)
    Unit cur, nxt; int ui = 0;
    if (!S.next(0, cur)) return;
    f32x4 acc[2][2][4][2];
#pragma unroll
    for (int a = 0; a < 2; ++a)
#pragma unroll
        for (int b = 0; b < 2; ++b)
#pragma unroll
            for (int m = 0; m < 4; ++m)
#pragma unroll
                for (int n = 0; n < 2; ++n) acc[a][b][m][n] = (f32x4){0.f, 0.f, 0.f, 0.f};
    bf16x8 At[4][2], B0[2][2], B1[2][2];
    const char* cA = (const char*)g.A + (size_t)cur.pm * tstep; const char* cB = (const char*)g.Bt + (size_t)cur.pn * tstep;
    S.a_ready(cur);
    if constexpr (SP2) {
        PG8_STAGE(PG8_SB(0, 0), cB, voffB); PG8_STAGE(PG8_SB(0, 1), cB + hstep, voffB); PG8_STAGE(PG8_SA(0, 0), cA, voffA); PG8_STAGE(PG8_SA(0, 1), cA + hstep, voffA);
        if (wr == 1) PG8_BAR;
        PG8_WAIT_V(2); PG8_BAR;
        PG8_STAGE(PG8_SB(1, 0), cB + kstep, voffB); PG8_STAGE(PG8_SA(1, 0), cA + kstep, voffA); PG8_STAGE(PG8_SB(1, 1), cB + hstep + kstep, voffB);
        PG8_WAIT_V(6); PG8_BAR;
    } else {
        PG8_STAGE(PG8_SB(0, 0), cB, voffB); PG8_STAGE(PG8_SA(0, 0), cA, voffA); PG8_STAGE(PG8_SB(0, 1), cB + hstep, voffB); PG8_STAGE(PG8_SA(0, 1), cA + hstep, voffA);
        if (wr == 1) PG8_BAR;
        PG8_WAIT_V(4); PG8_BAR;
        PG8_STAGE(PG8_SB(1, 0), cB + kstep, voffB); PG8_STAGE(PG8_SA(1, 0), cA + kstep, voffA); PG8_STAGE(PG8_SB(1, 1), cB + hstep + kstep, voffB);
        PG8_WAIT_V(6); PG8_BAR;
    }
    for (;;) {
        const bool has_next = S.next(ui + 1, nxt);
        const char* nA = has_next ? (const char*)g.A + (size_t)nxt.pm * tstep : cA; const char* nB = has_next ? (const char*)g.Bt + (size_t)nxt.pn * tstep : cB;
        for (int t = 0; t < nt; t += 2) {
            const bool last = (t == nt - 2);
            const char* a1 = cA + (size_t)(t + 1) * kstep;
            const char* a2 = last ? nA : cA + (size_t)(t + 2) * kstep; const char* b2 = last ? nB : cB + (size_t)(t + 2) * kstep;
            const char* a3 = a2 + kstep; const char* b3 = b2 + kstep;
            if (last && has_next) S.a_ready(nxt);
            if constexpr (SP2) {
            PG8_LDB(B0, 0, 0); PG8_LDB(B1, 0, 1); PG8_SCHED; PG8_LDA(At, 0, 0); PG8_STAGE(PG8_SA(1, 1), a1 + hstep, voffA);
            PG8_WAIT_V(8); PG8_WAIT_L(0); PG8_BAR; PG8_MMA(0, 0, At, B0); PG8_MMA(0, 1, At, B1); PG8_BAR; PG8_SCHED;
            PG8_LDA(At, 0, 1); PG8_STAGE(PG8_SB(0, 0), b2, voffB); PG8_STAGE(PG8_SB(0, 1), b2 + hstep, voffB); PG8_STAGE(PG8_SA(0, 0), a2, voffA);
            PG8_WAIT_V(8); PG8_WAIT_L(0); PG8_BAR; PG8_MMA(1, 0, At, B0); PG8_MMA(1, 1, At, B1); PG8_BAR; PG8_SCHED;
            PG8_LDB(B0, 1, 0); PG8_LDB(B1, 1, 1); PG8_SCHED; PG8_LDA(At, 1, 0); PG8_STAGE(PG8_SA(0, 1), a2 + hstep, voffA);
            PG8_WAIT_V(8); PG8_WAIT_L(0); PG8_BAR; PG8_MMA(0, 0, At, B0); PG8_MMA(0, 1, At, B1); PG8_BAR; PG8_SCHED;
            PG8_LDA(At, 1, 1); PG8_STAGE(PG8_SB(1, 0), b3, voffB); PG8_STAGE(PG8_SB(1, 1), b3 + hstep, voffB); PG8_STAGE(PG8_SA(1, 0), a3, voffA);
            PG8_WAIT_V(8); PG8_WAIT_L(0); PG8_BAR; PG8_MMA(1, 0, At, B0); PG8_MMA(1, 1, At, B1); PG8_BAR; PG8_SCHED;
            } else {
            PG8_LDB(B0, 0, 0); PG8_SCHED; PG8_LDA(At, 0, 0); PG8_STAGE(PG8_SA(1, 1), a1 + hstep, voffA);
            PG8_WAIT_L(8); PG8_BAR; PG8_WAIT_L(0); PG8_MMA(0, 0, At, B0); PG8_BAR; PG8_SCHED;
            PG8_LDB(B1, 0, 1); PG8_STAGE(PG8_SB(0, 0), b2, voffB);
            PG8_BAR; PG8_WAIT_L(0); PG8_MMA(0, 1, At, B1); PG8_BAR;
            PG8_LDA(At, 0, 1); PG8_STAGE(PG8_SA(0, 0), a2, voffA);
            PG8_BAR; PG8_WAIT_L(0); PG8_MMA(1, 0, At, B0); PG8_BAR; PG8_SCHED;
            PG8_STAGE(PG8_SB(0, 1), b2 + hstep, voffB);
            PG8_WAIT_V(6); PG8_BAR; PG8_MMA(1, 1, At, B1); PG8_BAR;
            PG8_LDB(B0, 1, 0); PG8_SCHED; PG8_LDA(At, 1, 0); PG8_STAGE(PG8_SA(0, 1), a2 + hstep, voffA);
            PG8_WAIT_L(8); PG8_BAR; PG8_WAIT_L(0); PG8_MMA(0, 0, At, B0); PG8_BAR; PG8_SCHED;
            PG8_LDB(B1, 1, 1); PG8_STAGE(PG8_SB(1, 0), b3, voffB);
            PG8_BAR; PG8_WAIT_L(0); PG8_MMA(0, 1, At, B1); PG8_BAR;
            PG8_LDA(At, 1, 1); PG8_STAGE(PG8_SA(1, 0), a3, voffA);
            PG8_BAR; PG8_WAIT_L(0); PG8_MMA(1, 0, At, B0); PG8_BAR; PG8_SCHED;
            PG8_STAGE(PG8_SB(1, 1), b3 + hstep, voffB);
            PG8_WAIT_V(6); PG8_BAR; PG8_MMA(1, 1, At, B1); PG8_BAR;
            }
        }
        if constexpr (ALIGN_EPI) { if (wr == 0) PG8_BAR; }
        if constexpr (!Epi::AFTER_DRAIN) { E(acc, cur, wr, wc, fr, fq); S.done(cur); }
        if (!has_next) break;
#pragma unroll
        for (int a = 0; a < 2; ++a)
#pragma unroll
            for (int b = 0; b < 2; ++b)
#pragma unroll
                for (int m = 0; m < 4; ++m)
#pragma unroll
                    for (int n = 0; n < 2; ++n) acc[a][b][m][n] = (f32x4){0.f, 0.f, 0.f, 0.f};
        cur = nxt; cA = nA; cB = nB; ++ui;
        if constexpr (ALIGN_EPI) { if (wr == 1) PG8_BAR; }
    }
    PG8_WAIT_V(0);
    if constexpr (!ALIGN_EPI) { if (wr == 0) PG8_BAR; }
    PG8_BAR;
    if constexpr (Epi::AFTER_DRAIN) { E.fused(acc, cur, wr, wc, fr, fq, lds, wid, lane); S.done(cur); }
#undef PG8_SA
#undef PG8_SB
#undef PG8_STAGE
#undef PG8_LDA
#undef PG8_LDB
#undef PG8_MMA
#undef PG8_WAIT_V
#undef PG8_WAIT_L
#undef PG8_BAR
#undef PG8_SCHED
}
}

namespace epi {
using namespace pg8;
__device__ __forceinline__ u32x4 pack8(f32x4 a, f32x4 b) { u32x4 w; w.x = cvt_pk_bf16(a[0], a[1]); w.y = cvt_pk_bf16(a[2], a[3]); w.z = cvt_pk_bf16(b[0], b[1]); w.w = cvt_pk_bf16(b[2], b[3]); return w; }
#define EPI_ROWS_BEGIN int row = u.pm * BM + wr * 64 + fr; _Pragma("unroll") for (int ai = 0; ai < 2; ++ai) { _Pragma("unroll") for (int m = 0; m < 4; ++m) {
#define EPI_LOAD_RS(ssqp) float rs8_[8]; { const int r0_ = u.pm * BM + wr * 64 + fr; _Pragma("unroll") for (int k_ = 0; k_ < 8; ++k_) rs8_[k_] = (ssqp)[r0_ + (k_ & 3) * 16 + (k_ >> 2) * HALF]; \
    _Pragma("unroll") for (int k_ = 0; k_ < 8; ++k_) rs8_[k_] = 1.0f / sqrtf(rs8_[k_] * (1.f / 2048.f) + 1e-6f); }
#define EPI_RS (rs8_[ai * 4 + m])
#define EPI_ROWS_END row += 16; asm volatile("" : "+v"(row) :: "memory"); } row += HALF - 64; }

struct EpiQKV {
    static constexpr bool PERM = true, AFTER_DRAIN = false;
    bf16_t* O; const float* cs; const float* sn;
    __device__ __forceinline__ void operator()(const f32x4 (&acc)[2][2][4][2], const Unit& u, int wr, int wc, int fr, int fq) const {
        const int colt = u.pn * BM, col0 = colt + wc * 32 + 8 * fq;
        const bool rope = (colt < 4096) && (wc == 0);
        int row = u.pm * BM + wr * 64 + fr;
#pragma unroll
        for (int ai = 0; ai < 2; ++ai) {
            f32x4 c4[4], s4[4];
            if (rope) {
#pragma unroll
                for (int m = 0; m < 4; ++m) { const unsigned to = (unsigned)(((row + 16 * m) * 16 + 4 * fq) * 4); c4[m] = *(const f32x4*)((const char*)cs + to); s4[m] = *(const f32x4*)((const char*)sn + to); } }
#pragma unroll
            for (int m = 0; m < 4; ++m) { bf16_t* rowp = O + (size_t)(row + 16 * m) * 6144 + col0;
#pragma unroll
                for (int bj = 0; bj < 2; ++bj) { f32x4 v0 = acc[ai][bj][m][0], v1 = acc[ai][bj][m][1];
                    if (rope) { const f32x4 a = v0 * c4[m] - v1 * s4[m], b = v1 * c4[m] + v0 * s4[m]; v0 = a; v1 = b; }
                    *(u32x4*)(rowp + bj * HALF) = pack8(v0, v1); } }
            row += HALF; asm volatile("" : "+v"(row) :: "memory");
        }
    }
};
__device__ __forceinline__ f32x4 bf_lo4(unsigned a, unsigned b) { return (f32x4){__builtin_bit_cast(float, a << 16), __builtin_bit_cast(float, a & 0xffff0000u), __builtin_bit_cast(float, b << 16), __builtin_bit_cast(float, b & 0xffff0000u)}; }
template <bool BASE_F32, bool OUT_F32, bool STAT> struct EpiResid {
    static constexpr bool PERM = true, AFTER_DRAIN = false;
    const void* base; void* out; float* ssq;
    __device__ __forceinline__ void operator()(const f32x4 (&acc)[2][2][4][2], const Unit& u, int wr, int wc, int fr, int fq) const {
        const int col0 = u.pn * BM + wc * 32 + 8 * fq;
        int row = u.pm * BM + wr * 64 + fr;
#pragma unroll
        for (int ai = 0; ai < 2; ++ai) {
            f32x4 bf_[BASE_F32 ? 4 : 1][2][2]; u32x4 bh_[BASE_F32 ? 1 : 4][2];
#pragma unroll
            for (int m = 0; m < 4; ++m)
#pragma unroll
                for (int bj = 0; bj < 2; ++bj) { const unsigned off = (unsigned)((row + 16 * m) * 2048 + col0 + bj * HALF);
                    if constexpr (BASE_F32) { bf_[m][bj][0] = *(const f32x4*)((const float*)base + off); bf_[m][bj][1] = *(const f32x4*)((const float*)base + off + 4); }
                    else bh_[m][bj] = *(const u32x4*)((const bf16_t*)base + off); }
#pragma unroll
            for (int m = 0; m < 4; ++m) { float s = 0.f;
#pragma unroll
                for (int bj = 0; bj < 2; ++bj) { const unsigned off = (unsigned)((row + 16 * m) * 2048 + col0 + bj * HALF); f32x4 h0, h1;
                    if constexpr (BASE_F32) { h0 = bf_[m][bj][0] + acc[ai][bj][m][0]; h1 = bf_[m][bj][1] + acc[ai][bj][m][1]; }
                    else { h0 = bf_lo4(bh_[m][bj].x, bh_[m][bj].y) + acc[ai][bj][m][0]; h1 = bf_lo4(bh_[m][bj].z, bh_[m][bj].w) + acc[ai][bj][m][1]; }
                    if constexpr (OUT_F32) { *(f32x4*)((float*)out + off) = h0; *(f32x4*)((float*)out + off + 4) = h1; }
                    else *(u32x4*)((bf16_t*)out + off) = pack8(h0, h1);
                    if constexpr (STAT) s += ((h0[0] * h0[0] + h0[1] * h0[1]) + (h0[2] * h0[2] + h0[3] * h0[3])) + ((h1[0] * h1[0] + h1[1] * h1[1]) + (h1[2] * h1[2] + h1[3] * h1[3])); }
                if constexpr (STAT) { s += __shfl_xor(s, 16); s += __shfl_xor(s, 32); if (fq == 0) atomicAdd(ssq + row + 16 * m, s); } }
            row += HALF; asm volatile("" : "+v"(row) :: "memory");
        }
    }
};
__device__ __forceinline__ float silu1(float x) { return x * __builtin_amdgcn_rcpf(1.f + __builtin_amdgcn_exp2f(-1.4426950408889634f * x)); }
struct EpiSwiGLU {
    static constexpr bool PERM = true, AFTER_DRAIN = false;
    bf16_t* O; const float* ssq;
    __device__ __forceinline__ void operator()(const f32x4 (&acc)[2][2][4][2], const Unit& u, int wr, int wc, int fr, int fq) const {
        const int col0 = u.pn * 128 + wc * 32 + 8 * fq;
        EPI_LOAD_RS(ssq)
        EPI_ROWS_BEGIN
            const float r = EPI_RS, rl = -1.4426950408889634f * r, r2 = r * r;
            f32x4 h[2];
#pragma unroll
            for (int n = 0; n < 2; ++n) { const f32x4 g = acc[ai][0][m][n], uu = acc[ai][1][m][n]; const f32x4 t = g * rl; f32x4 e;
#pragma unroll
                for (int j = 0; j < 4; ++j) e[j] = __builtin_amdgcn_exp2f(t[j]);
                const f32x4 d = e + 1.0f; f32x4 s;
#pragma unroll
                for (int j = 0; j < 4; ++j) s[j] = __builtin_amdgcn_rcpf(d[j]);
                h[n] = (g * uu) * (s * r2); }
            *(u32x4*)(O + (size_t)row * 5632 + col0) = pack8(h[0], h[1]);
        EPI_ROWS_END
    }
};
struct EpiA {
    static constexpr bool PERM = true, AFTER_DRAIN = false;
    bf16_t* C; bf16_t* CQ; bf16_t* KPE; const float* cs; const float* sn; const float* ssq; float* ssqC; float* ssqQ;
    __device__ __forceinline__ void operator()(const f32x4 (&acc)[2][2][4][2], const Unit& u, int wr, int wc, int fr, int fq) const {
        EPI_LOAD_RS(ssq)
        if (u.pn < 4) { bf16_t* dst = (u.pn < 2 ? C : CQ) + (u.pn & 1) * 256 + wc * 32 + 8 * fq;
            EPI_ROWS_BEGIN
                const float r = EPI_RS; float s = 0.f;
#pragma unroll
                for (int bj = 0; bj < 2; ++bj) { const f32x4 v0 = acc[ai][bj][m][0] * r, v1 = acc[ai][bj][m][1] * r;
                    s += ((v0[0] * v0[0] + v0[1] * v0[1]) + (v0[2] * v0[2] + v0[3] * v0[3])) + ((v1[0] * v1[0] + v1[1] * v1[1]) + (v1[2] * v1[2] + v1[3] * v1[3]));
                    *(u32x4*)((char*)dst + (unsigned)((row * 512 + bj * HALF) * 2)) = pack8(v0, v1); }
                s += __shfl_xor(s, 16); s += __shfl_xor(s, 32); if (fq == 0) atomicAdd((u.pn < 2 ? ssqC : ssqQ) + row, s);
            EPI_ROWS_END
        } else if (wc < 2) {
            EPI_ROWS_BEGIN
                const unsigned to = (unsigned)((row * 32 + 16 * wc + 4 * fq) * 4); const f32x4 c4 = *(const f32x4*)((const char*)cs + to), s4 = *(const f32x4*)((const char*)sn + to);
                const float r = EPI_RS;
                const f32x4 v0 = acc[ai][0][m][0] * r, v1 = acc[ai][0][m][1] * r;
                *(u32x4*)((char*)KPE + (unsigned)((row * 64 + 32 * wc + 8 * fq) * 2)) = pack8(v0 * c4 - v1 * s4, v1 * c4 + v0 * s4);
            EPI_ROWS_END
        }
    }
};
struct EpiRowScale {
    static constexpr bool PERM = true, AFTER_DRAIN = false;
    bf16_t* O; int ldc; const float* rs; int rope0; const float* cs; const float* sn; float mul;
    __device__ __forceinline__ void operator()(const f32x4 (&acc)[2][2][4][2], const Unit& u, int wr, int wc, int fr, int fq) const {
        const int colt = u.pn * BM, col0 = colt + wc * 32 + 8 * fq;
        const bool rope = colt >= rope0; const int w = wc & 1;
        int row = u.pm * BM + wr * 64 + fr;
        float r8[8];
#pragma unroll
        for (int k = 0; k < 8; ++k) r8[k] = rs[row + (k & 3) * 16 + (k >> 2) * HALF];
#pragma unroll
        for (int k = 0; k < 8; ++k) r8[k] = mul / sqrtf(r8[k] * (1.f / 512.f) + 1e-6f);
#pragma unroll
        for (int ai = 0; ai < 2; ++ai) {
            f32x4 c4[4], s4[4];
            if (rope) {
#pragma unroll
                for (int m = 0; m < 4; ++m) { const unsigned to = (unsigned)(((row + 16 * m) * 32 + 16 * w + 4 * fq) * 4); c4[m] = *(const f32x4*)((const char*)cs + to); s4[m] = *(const f32x4*)((const char*)sn + to); } }
#pragma unroll
            for (int m = 0; m < 4; ++m) { const float r = r8[ai * 4 + m];
#pragma unroll
                for (int bj = 0; bj < 2; ++bj) { f32x4 v0 = acc[ai][bj][m][0] * r, v1 = acc[ai][bj][m][1] * r;
                    if (rope) { const f32x4 a = v0 * c4[m] - v1 * s4[m], b = v1 * c4[m] + v0 * s4[m]; v0 = a; v1 = b; }
                    *(u32x4*)((char*)O + (unsigned)(((row + 16 * m) * ldc + col0 + bj * HALF) * 2)) = pack8(v0, v1); } }
            row += HALF; asm volatile("" : "+v"(row) :: "memory");
        }
    }
};
#undef EPI_ROWS_BEGIN
#undef EPI_ROWS_END
#undef EPI_LOAD_RS
#undef EPI_RS
}

namespace att {
typedef unsigned short bf16_t;
typedef short bf16x8 __attribute__((ext_vector_type(8)));
typedef short s16x4 __attribute__((ext_vector_type(4)));
typedef float f32x16 __attribute__((ext_vector_type(16)));
typedef float f32x4 __attribute__((ext_vector_type(4)));
typedef unsigned u32x4 __attribute__((ext_vector_type(4)));
constexpr int NW = 8, QBLK = 32, KVBLK = 64, QB = NW * QBLK, D = 128;
constexpr int SHM_V = KVBLK * D * 2, SHM_K = KVBLK * D * 2, SHM_K2 = KVBLK * 64 * 2;
constexpr int OFF_WS = 2 * SHM_V + 2 * SHM_K, OFF_K2 = OFF_WS + NW * 64 * 4, OFF_QPE = OFF_K2 + 2 * SHM_K2, LDS_BYTES = OFF_QPE + NW * 4096;
constexpr float THR = 8.f;
#define ALDS __attribute__((address_space(3)))
#define KSWZ(row, colB) ((row) * 256 + ((colB) ^ (((row) & 7) << 4)))
#define SBAR() __builtin_amdgcn_sched_barrier(0)
__device__ __forceinline__ int v_st(int k, int c) { const int kk = (k & ~0xC) | ((k & 4) << 1) | ((k & 8) >> 1); return ((kk >> 3) * 4 + (c >> 5)) * 512 + ((kk & 7) * 32 + (c & 31)) * 2; }
__device__ __forceinline__ int v_rd_base(int lane) { return ((lane & 3) << 3) | (((lane >> 2) & 3) << 6) | (((lane >> 4) & 1) << 5) | (((lane >> 5) & 1) << 8); }
constexpr int v_rd_off(int d0, int ks, int half) { return d0 * 512 + ks * 4096 + half * 2048; }
__device__ __forceinline__ int crow(int r, int hi) { return (r & 3) + 8 * (r >> 2) + 4 * hi; }
__device__ __forceinline__ unsigned cvtpk(float lo, float hi) {
    unsigned r; asm volatile("v_cvt_pk_bf16_f32 %0, %1, %2" : "=v"(r) : "v"(lo), "v"(hi)); return r;
}
__device__ __forceinline__ bf16x8 pack8(f32x4 a, f32x4 b) {
    u32x4 w = {cvtpk(a[0], a[1]), cvtpk(a[2], a[3]), cvtpk(b[0], b[1]), cvtpk(b[2], b[3])};
    return *reinterpret_cast<bf16x8*>(&w);
}
__device__ __forceinline__ bf16x8 load8(const bf16_t* p) { return *reinterpret_cast<const bf16x8*>(p); }
__device__ __forceinline__ void partialSM(f32x16& p0, f32x16& p1, float& m_reg, float& mn, float& alpha, const float SCALE) {
    float pmax = p0[0]; for (int r = 1; r < 16; ++r) pmax = fmaxf(pmax, p0[r]); for (int r = 0; r < 16; ++r) pmax = fmaxf(pmax, p1[r]);
    { auto rr = __builtin_amdgcn_permlane32_swap(__float_as_uint(pmax), __float_as_uint(pmax), false, false);
      pmax = fmaxf(__uint_as_float(rr[0]), __uint_as_float(rr[1])); }
    const float C2 = 1.4426950408889634f * SCALE;
    if (__builtin_expect(__all((pmax - m_reg) * SCALE <= THR), 1)) { mn = m_reg; alpha = 1.f; }
    else { mn = fmaxf(m_reg, pmax); alpha = __builtin_amdgcn_exp2f((m_reg - mn) * C2); m_reg = mn; }
    const float mnL = -mn * C2;
    for (int r = 0; r < 16; ++r) p0[r] = fmaf(p0[r], C2, mnL); for (int r = 0; r < 16; ++r) p1[r] = fmaf(p1[r], C2, mnL);
    for (int r = 0; r < 16; ++r) p0[r] = __builtin_amdgcn_exp2f(p0[r]);
}
__device__ __forceinline__ void partialSM2(f32x16& p0, f32x16& p1, float& mhat, f32x16& negm, float& alpha, const bool first_tile) {
    float pmax = p0[0]; for (int r = 1; r < 16; ++r) pmax = fmaxf(pmax, p0[r]); for (int r = 0; r < 16; ++r) pmax = fmaxf(pmax, p1[r]);
    { auto rr = __builtin_amdgcn_permlane32_swap(__float_as_uint(pmax), __float_as_uint(pmax), false, false);
      pmax = fmaxf(__uint_as_float(rr[0]), __uint_as_float(rr[1])); }
    constexpr float THR2 = THR * 1.4426950408889634f;
    alpha = 1.f;
    if (first_tile || !__all(pmax <= THR2)) { const float dl = first_tile ? pmax : fmaxf(pmax, 0.f); mhat += dl;
        for (int r = 0; r < 16; ++r) { p0[r] -= dl; p1[r] -= dl; }
        for (int r = 0; r < 16; ++r) negm[r] = -mhat;
        alpha = __builtin_amdgcn_exp2f(-dl); }
    for (int r = 0; r < 16; ++r) p0[r] = __builtin_amdgcn_exp2f(p0[r]);
}
template <int KB, bool SK, bool MLA>
__device__ __forceinline__ void qkt(f32x16& p0, f32x16& p1, ALDS const char* K_lds, ALDS const char* K2_lds, ALDS const char* Qpe_lds, int r32, int hi, const bf16x8* qr, bool act, const f32x16& cinit) {
    if (SK && !act) { const float NEG = -__builtin_inff();
#pragma unroll
        for (int r = 0; r < 16; ++r) { p0[r] = NEG; p1[r] = NEG; } return; }
    if constexpr (MLA) { p0 = cinit; p1 = cinit; } else { p0 = f32x16{}; p1 = f32x16{}; }
    ALDS const char* kb[4];
#pragma unroll
    for (int dd = 0; dd < 4; ++dd) kb[dd] = K_lds + KB * SHM_K + KSWZ(r32, (dd * 16 + hi * 8) * 2);
    ALDS const char* k2b = K2_lds + KB * SHM_K2 + r32 * 128; const int k2x = (r32 >> 1) & 7;
    constexpr int NS = MLA ? 12 : 8;
    bf16x8 fa[3], fb[3], fq[3];
#define QKT_LOAD(d0_, B) do {                                                                                                              \
        if ((d0_) < 8) { ALDS const char* a_ = kb[(d0_) & 3] + ((d0_) >> 2) * 128; fa[B] = *(ALDS const bf16x8*)(a_); fb[B] = *(ALDS const bf16x8*)(a_ + 32 * 256); }   \
        else { ALDS const char* a_ = k2b + (((((d0_) - 8) * 2 + hi) ^ k2x) << 4); fa[B] = *(ALDS const bf16x8*)(a_); fb[B] = *(ALDS const bf16x8*)(a_ + 32 * 128);     \
               fq[B] = *(ALDS const bf16x8*)(Qpe_lds + ((d0_) - 8) * 1024); } } while (0)
    QKT_LOAD(0, 0); QKT_LOAD(1, 1);
#pragma unroll
    for (int d0 = 0; d0 < NS; ++d0) {
        if (d0 + 2 < NS) { if ((d0 + 2) % 3 == 0) QKT_LOAD(d0 + 2, 0); else if ((d0 + 2) % 3 == 1) QKT_LOAD(d0 + 2, 1); else QKT_LOAD(d0 + 2, 2); }
        SBAR();
        { const bf16x8 q_ = d0 < 8 ? qr[d0 < 8 ? d0 : 0] : fq[d0 % 3];
          p0 = __builtin_amdgcn_mfma_f32_32x32x16_bf16(fa[d0 % 3], q_, p0, 0, 0, 0);
          p1 = __builtin_amdgcn_mfma_f32_32x32x16_bf16(fb[d0 % 3], q_, p1, 0, 0, 0); }
        SBAR();
    }
#undef QKT_LOAD
}
__device__ __forceinline__ void mask_tile(f32x16& p0, f32x16& p1, int dq, unsigned W) {
    const float NEG = -__builtin_inff();
#pragma unroll
    for (int r = 0; r < 16; ++r) {
        const int c = (r & 3) + 8 * (r >> 2);
        if ((unsigned)(dq - c) >= W) p0[r] = NEG;
        if ((unsigned)(dq - c - 32) >= W) p1[r] = NEG;
    }
}
__device__ __forceinline__ void finishSM(f32x16& p0, f32x16& p1, float alpha, float& l_reg, bf16x8& pa0, bf16x8& pa1, bf16x8& pa2, bf16x8& pa3) {
    for (int r = 0; r < 16; ++r) p1[r] = __builtin_amdgcn_exp2f(p1[r]);
    float ps = 0; for (int r = 0; r < 16; ++r) ps += p0[r]; for (int r = 0; r < 16; ++r) ps += p1[r];
    { auto rr = __builtin_amdgcn_permlane32_swap(__float_as_uint(ps), __float_as_uint(ps), false, false);
      ps = __uint_as_float(rr[0]) + __uint_as_float(rr[1]); }
    l_reg = l_reg * alpha + ps;
#define PK4(P, B_, OUT) do { unsigned a0 = cvtpk(P[B_+0], P[B_+1]), a1 = cvtpk(P[B_+2], P[B_+3]);                          \
        unsigned b0 = cvtpk(P[B_+4], P[B_+5]), b1 = cvtpk(P[B_+6], P[B_+7]);                                             \
        auto r0 = __builtin_amdgcn_permlane32_swap(a0, b0, false, false); auto r1 = __builtin_amdgcn_permlane32_swap(a1, b1, false, false); \
        u32x4 w = {r0[0], r1[0], r0[1], r1[1]}; OUT = *reinterpret_cast<bf16x8*>(&w); } while (0)
    PK4(p0, 0, pa0); PK4(p0, 8, pa1); PK4(p1, 0, pa2); PK4(p1, 8, pa3);
#undef PK4
}
template <int VB, bool SK>
__device__ __forceinline__ void pv_tile(f32x16* o, int vb0, bf16x8 pa0, bf16x8 pa1, bf16x8 pa2, bf16x8 pa3, bool act) {
    if (SK && !act) return;
    s16x4 L0[4], H0[4], L1[4], H1[4];
#define TRRD(dst, off) asm volatile("ds_read_b64_tr_b16 %0, %1 offset:%2" : "=&v"(dst) : "v"(vb0), "i"(off) : "memory")
#define PV_ISSUE(d0, L, H) do { constexpr int b_ = VB * SHM_V + v_rd_off(d0, 0, 0);     \
        TRRD(L[0], b_); TRRD(H[0], b_ + 2048); TRRD(L[1], b_ + 4096); TRRD(H[1], b_ + 6144); TRRD(L[2], b_ + 8192); TRRD(H[2], b_ + 10240); TRRD(L[3], b_ + 12288); TRRD(H[3], b_ + 14336); } while (0)
#define PV_MMA(d0, L, H) do { SBAR();                                                                                                   \
        o[d0] = __builtin_amdgcn_mfma_f32_32x32x16_bf16(pa0, (bf16x8){L[0][0], L[0][1], L[0][2], L[0][3], H[0][0], H[0][1], H[0][2], H[0][3]}, o[d0], 0, 0, 0);   \
        o[d0] = __builtin_amdgcn_mfma_f32_32x32x16_bf16(pa1, (bf16x8){L[1][0], L[1][1], L[1][2], L[1][3], H[1][0], H[1][1], H[1][2], H[1][3]}, o[d0], 0, 0, 0);   \
        o[d0] = __builtin_amdgcn_mfma_f32_32x32x16_bf16(pa2, (bf16x8){L[2][0], L[2][1], L[2][2], L[2][3], H[2][0], H[2][1], H[2][2], H[2][3]}, o[d0], 0, 0, 0);   \
        o[d0] = __builtin_amdgcn_mfma_f32_32x32x16_bf16(pa3, (bf16x8){L[3][0], L[3][1], L[3][2], L[3][3], H[3][0], H[3][1], H[3][2], H[3][3]}, o[d0], 0, 0, 0); SBAR(); } while (0)
    PV_ISSUE(0, L0, H0);
    PV_ISSUE(1, L1, H1); asm volatile("s_waitcnt lgkmcnt(8)" ::: "memory"); PV_MMA(0, L0, H0);
    PV_ISSUE(2, L0, H0); asm volatile("s_waitcnt lgkmcnt(8)" ::: "memory"); PV_MMA(1, L1, H1);
    PV_ISSUE(3, L1, H1); asm volatile("s_waitcnt lgkmcnt(8)" ::: "memory"); PV_MMA(2, L0, H0);
    asm volatile("s_waitcnt lgkmcnt(0)" ::: "memory"); PV_MMA(3, L1, H1);
#undef PV_ISSUE
#undef PV_MMA
#undef TRRD
}

struct Pitch { int qp, kp, vp, op, lp, mo, ml; };
struct BlockRef { const bf16_t* Q; const bf16_t* K; const bf16_t* V; bf16_t* O; const bf16_t* Qpe; const bf16_t* Kpe; float* LSE; const bf16_t* Om; const float* Lm; int P0; int pad; };
__device__ __forceinline__ int swa_jlo(int P0, int W) { const int lowk = P0 - W + 1; return lowk > 0 ? lowk / KVBLK : 0; }
#define ROWP(p, pitch, k0, rr) ((p) + (size_t)((k0) + (rr)) * (size_t)(pitch) + sc)
#define VMW() asm volatile("s_waitcnt vmcnt(0)" ::: "memory")
__device__ __forceinline__ void glds16(const void* gsrc, unsigned lds_dst) { unsigned keep;
    asm volatile("s_mov_b32 %0, m0\n\ts_mov_b32 m0, %2\n\ts_nop 0\n\tglobal_load_lds_dwordx4 %1, off\n\ts_mov_b32 m0, %0" : "=&s"(keep) : "v"(gsrc), "s"(lds_dst) : "memory"); }
#define DMA_TILE_P(Kp, Vp, Kpep, k0, bf) do { const char* vb_ = (const char*)((Vp) + (size_t)(k0) * (size_t)pt.vp); const char* kb_ = (const char*)((Kp) + (size_t)(k0) * (size_t)pt.kp);                   \
        glds16(vb_ + vof0, (unsigned)__builtin_amdgcn_readfirstlane(ldsV + (bf) * SHM_V)); glds16(vb_ + vof1, (unsigned)__builtin_amdgcn_readfirstlane(ldsV + (bf) * SHM_V + 8192));  \
        glds16(kb_ + kof0, (unsigned)__builtin_amdgcn_readfirstlane(ldsK + (bf) * SHM_K)); glds16(kb_ + kof1, (unsigned)__builtin_amdgcn_readfirstlane(ldsK + (bf) * SHM_K + 8192));  \
        if constexpr (MLA) glds16((const char*)((Kpep) + (size_t)(k0) * 64) + k2of, (unsigned)__builtin_amdgcn_readfirstlane(ldsK2 + (bf) * SHM_K2)); } while (0)
#define DMA_TILE(k0, bf) DMA_TILE_P(Kh, Vh, Kpeh, k0, bf)
#define Q_LOADS(B) do { _Pragma("unroll") for (int d0 = 0; d0 < 8; ++d0) qr[d0] = load8((B).Q + (size_t)(wid * QBLK + r32) * pt.qp + d0 * 16 + hi * 8);               \
        if constexpr (MLA) { _Pragma("unroll") for (int d0 = 0; d0 < 4; ++d0) qpe[d0] = load8((B).Qpe + (size_t)(wid * QBLK + r32) * pt.qp + d0 * 16 + hi * 8); } } while (0)
template <bool MLA, bool SK, bool LSEOUT, bool MERGE>
__device__ __forceinline__ void attn_block(const BlockRef& cur, const BlockRef& nxt, const bool has_next, const bool first, int skv, int W, char* lds, const Pitch& pt, const float SCALE, const int wave_, bf16x8 (&qr)[8], bf16x8 (&qpe)[4]) {
    int tid_ = wave_ * 64 + mk_lane(); asm volatile("" : "+v"(tid_));
    const int tid = tid_, wid = __builtin_amdgcn_readfirstlane(tid >> 6), lane = tid & 63, r32 = lane & 31, hi = lane >> 5;
    const int j_lo = swa_jlo(cur.P0, W);
    int j_hi = (cur.P0 + QB - 1) / KVBLK + 1; if (j_hi > skv / KVBLK) j_hi = skv / KVBLK;
    const int NT = j_hi - j_lo;
    const int qlo = cur.P0 + wid * QBLK, qm = qlo + r32 - 4 * hi;
    ALDS char* ldsa = (ALDS char*)lds; ALDS char* V_lds = ldsa; ALDS char* K_lds = ldsa + 2 * SHM_V; ALDS char* K2_lds = ldsa + OFF_K2; ALDS char* Qpe_lds = ldsa + OFF_QPE + wid * 4096 + lane * 16;
    ALDS float* ws = (ALDS float*)(ldsa + OFF_WS) + wid * 64; ALDS float* li_l = ws; ALDS float* al_l = ws + 32;
    float m_reg = -1e30f, l_reg = 0; f32x16 o[4] = {};
    const int krow = 4 * wid + (lane >> 4), kcol = ((lane & 15) ^ (krow & 7)) * 8;
    const int vkk = (wid >> 1) * 8 + ((lane >> 2) & 7), vkey = (vkk & ~0xC) | ((vkk & 4) << 1) | ((vkk & 8) >> 1), vcol = (wid & 1) * 64 + (lane >> 5) * 32 + (lane & 3) * 8;
    const int k2row = 8 * wid + (lane >> 3), k2col = ((lane & 7) ^ ((k2row >> 1) & 7)) * 8;
    const unsigned kof0 = (unsigned)((krow * pt.kp + kcol) * 2), kof1 = kof0 + (unsigned)(32 * pt.kp * 2), vof0 = (unsigned)((vkey * pt.vp + vcol) * 2), vof1 = vof0 + (unsigned)(32 * pt.vp * 2), k2of = (unsigned)((k2row * 64 + k2col) * 2);
    (void)k2of;
    const unsigned lds0 = (unsigned)(uintptr_t)lds; const unsigned ldsV = lds0 + wid * 1024, ldsK = lds0 + 2 * SHM_V + wid * 1024, ldsK2 = lds0 + OFF_K2 + wid * 1024; (void)ldsK2;
    const int vb0 = (int)(unsigned)(uintptr_t)V_lds + v_rd_base(lane);
    const bf16_t* Kh = cur.K; const bf16_t* Vh = cur.V; const bf16_t* Kpeh = cur.Kpe;
#define RESC(a) do { if (__any((a) < 1.f)) { if (hi == 0) al_l[r32] = (a); asm volatile("s_waitcnt lgkmcnt(0)" ::: "memory");              \
                     for (int d_ = 0; d_ < 4; ++d_) for (int r = 0; r < 16; ++r) o[d_][r] *= al_l[crow(r, hi)]; } } while (0)
#define KBASE(t) ((j_lo + (t)) * KVBLK)
#define ACT(t) (KBASE(t) <= qlo + QBLK - 1 && KBASE(t) + KVBLK - 1 >= qlo - W + 1)
#define MASKT(P0_, P1_, t) do { const int kb_ = KBASE(t); if ((!SK || ACT(t)) && (kb_ + KVBLK - 1 > qlo || kb_ <= qlo + QBLK - 1 - W)) mask_tile(P0_, P1_, qm - kb_, (unsigned)W); } while (0)
    if (first) { DMA_TILE(KBASE(0), 0); Q_LOADS(cur); }
    if constexpr (MLA) {
#pragma unroll
        for (int d0 = 0; d0 < 4; ++d0) *(ALDS bf16x8*)(Qpe_lds + d0 * 1024) = qpe[d0]; }
    VMW();
    __syncthreads();
    bf16x8 pa0, pa1, pa2, pa3;
    f32x16 negm = {}; float mhat = 0.f; (void)mhat;
#define STEP(t, B) do { f32x16 p0_, p1_; float mn_, al_;                                                                       \
        if ((t) + 1 < NT) { DMA_TILE(KBASE((t) + 1), 1 - B); } SBAR();                                                        \
        qkt<B, SK, MLA>(p0_, p1_, K_lds, K2_lds, Qpe_lds, r32, hi, qr, ACT(t), negm);                                         \
        MASKT(p0_, p1_, (t));                                                                                                 \
        if constexpr (MLA) { partialSM2(p0_, p1_, mhat, negm, al_, (t) == 0); (void)mn_; } else { partialSM(p0_, p1_, m_reg, mn_, al_, SCALE); } \
        RESC(al_);                                                                                                            \
        finishSM(p0_, p1_, al_, l_reg, pa0, pa1, pa2, pa3); SBAR();                                                           \
        pv_tile<B, SK>(o, vb0, pa0, pa1, pa2, pa3, ACT(t));                                                                   \
        VMW(); __syncthreads(); } while (0)
    int t = 0;
    for (; t + 1 < NT; t += 2) { STEP(t, 0); STEP(t + 1, 1); }
    if (t < NT) { STEP(t, 0); }
    if (has_next) { DMA_TILE_P(nxt.K, nxt.V, nxt.Kpe, swa_jlo(nxt.P0, W) * KVBLK, 0); Q_LOADS(nxt); }
    if (hi == 0) li_l[r32] = l_reg; asm volatile("s_waitcnt lgkmcnt(0)" ::: "memory");
    if constexpr (LSEOUT) { if (hi == 0) cur.LSE[(size_t)(wid * QBLK + r32) * pt.lp] = m_reg * SCALE + __logf(l_reg); }
    float rli[16];
#pragma unroll
    for (int r = 0; r < 16; ++r) rli[r] = __builtin_amdgcn_rcpf(li_l[crow(r, hi)]);
    if constexpr (MERGE) { if (hi == 0) al_l[r32] = m_reg * SCALE + __logf(l_reg); asm volatile("s_waitcnt lgkmcnt(0)" ::: "memory"); }
    { ALDS char* stg = ldsa + (wid < 4 ? SHM_V + wid * 4096 : 2 * SHM_V + SHM_K + (wid - 4) * 4096);
      char* Ow = (char*)(cur.O + (size_t)(wid * QBLK) * pt.op);
#pragma unroll
      for (int p = 0; p < 2; ++p) {
#pragma unroll
        for (int r = 8 * p; r < 8 * p + 8; ++r) { const int orow = crow(r, hi) - 16 * p;
#pragma unroll
            for (int d0 = 0; d0 < 4; ++d0) { const float v = o[d0][r] * rli[r]; *(ALDS unsigned short*)(stg + orow * 256 + (d0 * 32 + r32) * 2) = (unsigned short)cvtpk(v, v); } }
        if constexpr (!MERGE) {
#pragma unroll
          for (int it = 0; it < 4; ++it) { const int r16 = it * 4 + (lane >> 4), row = 16 * p + r16, ch = lane & 15;
              const u32x4 w = *(ALDS const u32x4*)(stg + r16 * 256 + ch * 16); *(u32x4*)(Ow + (size_t)row * (size_t)(pt.op * 2) + ch * 16) = w; }
        } else {
          const char* O0 = (const char*)(cur.Om + (size_t)(wid * QBLK) * pt.op); const float* L0 = cur.Lm + (size_t)(wid * QBLK) * pt.lp;
#pragma unroll
          for (int it = 0; it < 4; ++it) { const int r16 = it * 4 + (lane >> 4), row = 16 * p + r16, ch = lane & 15;
              const float l2 = al_l[row], l0 = L0[(size_t)row * pt.lp], l1 = L0[(size_t)row * pt.lp + pt.ml], mx = fmaxf(l0, fmaxf(l1, l2));
              float e0 = __expf(l0 - mx), e1 = __expf(l1 - mx), e2 = __expf(l2 - mx); const float inv = 1.f / (e0 + e1 + e2); e0 *= inv; e1 *= inv; e2 *= inv;
              const size_t go = (size_t)row * (size_t)(pt.op * 2) + ch * 16;
              const u32x4 a0 = *(const u32x4*)(O0 + go), a1 = *(const u32x4*)(O0 + (size_t)pt.mo * 2 + go), a2 = *(ALDS const u32x4*)(stg + r16 * 256 + ch * 16); u32x4 w;
#pragma unroll
              for (int k = 0; k < 4; ++k) { const float lo = e0 * __builtin_bit_cast(float, a0[k] << 16) + e1 * __builtin_bit_cast(float, a1[k] << 16) + e2 * __builtin_bit_cast(float, a2[k] << 16);
                  const float hh = e0 * __builtin_bit_cast(float, a0[k] & 0xffff0000u) + e1 * __builtin_bit_cast(float, a1[k] & 0xffff0000u) + e2 * __builtin_bit_cast(float, a2[k] & 0xffff0000u);
                  w[k] = cvtpk(lo, hh); }
              *(u32x4*)(Ow + go) = w; }
        }
      } }
    if (!has_next) __syncthreads();
#undef RESC
#undef KBASE
#undef ACT
#undef MASKT
#undef STEP
}
#undef ROWP
#undef VMW
#undef DMA_TILE
#undef DMA_TILE_P
#undef Q_LOADS
template <bool MLA, bool SK, bool LSEOUT, bool MERGE, class Deal>
__device__ __forceinline__ void attn_phase(char* lds, const Deal& dl, int skv, int W, const Pitch& pt, const float SCALE, const int wave_) {
    BlockRef cur, nxt;
    if (!dl.get(0, cur)) return;
    bf16x8 qr[8], qpe[4]; bool first = true;
    for (int i = 0;; ++i) {
        const bool more = dl.get(i + 1, nxt);
        if (!more) nxt = cur;
        attn_block<MLA, SK, LSEOUT, MERGE>(cur, nxt, more, first, skv, W, lds, pt, SCALE, wave_, qr, qpe);
        if (!more) break;
        cur = nxt; first = false;
    }
}
#undef KSWZ
#undef SBAR
#undef ALDS
}

#ifndef LAS
#define LAS __attribute__((address_space(3)))
#endif
#define XB_TMO      128
#define XB_XCNT(j)  (256  + 64 * (j))
#define XB_XSUB(j)  (1280 + 64 * (j))
#define XB_XGEN(j)  (2304 + 64 * (j))
#define XB_TOP      3328
#define XB_TOPGEN   3392
#define XCD_BAR_WORDS 3456
#define XB_SPIN_CAP (1u << 18)

__device__ __forceinline__ unsigned xb_ld(unsigned* p)              { return __hip_atomic_load(p, __ATOMIC_RELAXED, __HIP_MEMORY_SCOPE_AGENT); }
__device__ __forceinline__ unsigned xb_add(unsigned* p, unsigned v) { return __hip_atomic_fetch_add(p, v, __ATOMIC_RELAXED, __HIP_MEMORY_SCOPE_AGENT); }
__device__ __forceinline__ unsigned xb_xcc_id() { return (unsigned)__builtin_amdgcn_s_getreg((3 << 11) | 20) & 0xFu; }
#define XB_SPIN(cond, bar) do { unsigned _sp = 0; while (cond) { __builtin_amdgcn_s_sleep(1); \
    if ((++_sp & 255u) == 0u) { if (xb_ld(&(bar)[XB_TMO])) break; if (_sp > XB_SPIN_CAP) { atomicAdd(&(bar)[XB_TMO], 1u); break; } } } } while (0)

struct XcdBarrier {
    unsigned* bar; unsigned x;
    volatile LAS unsigned* st;
};

__device__ __forceinline__ XcdBarrier xcd_barrier_post(unsigned* bar, volatile LAS unsigned* st, const bool is_t0) {
    XcdBarrier b; b.bar = bar; b.x = xb_xcc_id(); b.st = st;
    if (is_t0) (void)xb_add(&bar[XB_XCNT(b.x)], 1u);
    return b;
}
__device__ __forceinline__ void xcd_barrier_complete(unsigned* bar, unsigned x, unsigned& nloc, unsigned& nx) {
    const unsigned G = gridDim.x * gridDim.y * gridDim.z;
    unsigned sum, cnt, mine, sp = 0u;
    for (;;) {
        sum = 0u; cnt = 0u; mine = 0u;
#pragma unroll
        for (unsigned j = 0; j < 16; ++j) { const unsigned c = xb_ld(&bar[XB_XCNT(j)]); sum += c; cnt += (c > 0u) ? 1u : 0u; mine = (j == x) ? c : mine; }
        if (sum == G) break;
        __builtin_amdgcn_s_sleep(1);
        if ((++sp & 255u) == 0u) { if (xb_ld(&bar[XB_TMO])) break; if (sp > XB_SPIN_CAP) { atomicAdd(&bar[XB_TMO], 1u); break; } }
    }
    nloc = mine > 0u ? mine : 1u; nx = cnt > 0u ? cnt : 1u;
}

__device__ __forceinline__ void xcd_barrier(const XcdBarrier& b, const bool is_t0) {
    asm volatile("s_waitcnt vmcnt(0)" ::: "memory");
    __syncthreads();
    if (is_t0) {
        unsigned* bar = b.bar;
        __builtin_amdgcn_s_waitcnt(0);
        unsigned nloc = b.st[0], nx = b.st[1];
        if (nloc == 0u) { xcd_barrier_complete(bar, b.x, nloc, nx); b.st[0] = nloc; b.st[1] = nx; }
        const unsigned old = xb_add(&bar[XB_XSUB(b.x)], 1u);
        const unsigned gen = old / nloc;
        if (old + 1u == (gen + 1u) * nloc) {
            __builtin_amdgcn_fence(__ATOMIC_RELEASE, "agent");
            asm volatile("s_waitcnt vmcnt(0)" ::: "memory");
            const unsigned og = xb_add(&bar[XB_TOP], 1u);
            const unsigned tg = og / nx;
            if (og + 1u == (tg + 1u) * nx) xb_add(&bar[XB_TOPGEN], 1u);
            else XB_SPIN(xb_ld(&bar[XB_TOPGEN]) == tg, bar);
            __builtin_amdgcn_fence(__ATOMIC_ACQUIRE, "agent");
            xb_add(&bar[XB_XGEN(b.x)], 1u);
            asm volatile("s_waitcnt vmcnt(0)" ::: "memory");
        } else {
            XB_SPIN(xb_ld(&bar[XB_XGEN(b.x)]) == gen, bar);
            __builtin_amdgcn_fence(__ATOMIC_ACQUIRE, "agent");
            asm volatile("s_waitcnt vmcnt(0)" ::: "memory");
        }
    }
    __syncthreads();
}

constexpr int S_ = 16384, DM = 2048, FF = 5632, NQG = 6144;
constexpr float EPS = 1e-6f;
constexpr size_t MiB = 1u << 20;
constexpr size_t WS_RSKV = 0, WS_RSQ = 65536, WS_BAR = 131072, WS_SSQ = 262144;
constexpr size_t WS_COSA = 1 * MiB, WS_SINA = 2 * MiB, WS_COSB = 3 * MiB, WS_SINB = 5 * MiB;
constexpr size_t WS_LSE = 7 * MiB;
constexpr size_t WS_WQKV = 10 * MiB, WS_WOA = 82 * MiB, WS_WA = 90 * MiB, WS_WKVB = 95 * MiB, WS_WQB = 99 * MiB, WS_WOB = 102 * MiB;
constexpr size_t WS_WGU = 110 * MiB  , WS_WDN = 198 * MiB  ;
constexpr size_t WS_XN = 242 * MiB;
constexpr size_t WS_BIG = 306 * MiB;
constexpr size_t WS_END = 578 * MiB;
constexpr size_t BIG_QKVG = 0, BIG_OG2 = 192 * MiB, BIG_HB = 0, BIG_H1 = 64 * MiB, BIG_KV = 0, BIG_Q = 128 * MiB, BIG_C = 224 * MiB, BIG_CQ = 240 * MiB, BIG_KPE = 256 * MiB;
constexpr int RING_BYTES = 131072, LDS_TOTAL = 135168;
static_assert(att::LDS_BYTES <= LDS_TOTAL - 128, "attention scratch fits below the LDS control words");

typedef unsigned short bf16;
typedef unsigned v4u __attribute__((ext_vector_type(4)));
typedef float f32x4 __attribute__((ext_vector_type(4)));
#define LDS_WAIT() asm volatile("s_waitcnt lgkmcnt(0)" ::: "memory")
__device__ __forceinline__ unsigned f2bf(float f) { unsigned u = __builtin_bit_cast(unsigned, f); return (u + 0x7fffu + ((u >> 16) & 1u)) >> 16; }
__device__ __forceinline__ unsigned pk2(float lo, float hi) { return pg8::cvt_pk_bf16(lo, hi); }
__device__ __forceinline__ float bflo(unsigned w) { return __builtin_bit_cast(float, w << 16); }
__device__ __forceinline__ float bfhi(unsigned w) { return __builtin_bit_cast(float, w & 0xffff0000u); }
__device__ __forceinline__ float wave_sum(float v) {
#pragma unroll
    for (int o = 1; o < 64; o <<= 1) v += __shfl_xor(v, o);
    return v;
}
template <int MAP> __device__ __forceinline__ int dst_row(int n) {
    if constexpr (MAP == 1) { const int r = n % NQG, t = r / 2048, d = r & 127; if (t < 2 && d < 32) return n - d + 8 * ((d >> 2) & 3) + 4 * (d >> 4) + (d & 3); return n; }
    else if constexpr (MAP == 2) { if (n < 512) return n; const int d = n - 512; return 1024 + 32 * ((d >> 4) & 1) + 8 * ((d >> 2) & 3) + 4 * (d >> 5) + (d & 3); }
    else if constexpr (MAP == 3) { return 512 + n; }
    else if constexpr (MAP == 4) { const int h = n / 192, e = n % 192; if (e < 128) return h * 128 + e; const int d = e - 128; return 2048 + h * 64 + 32 * ((d >> 4) & 1) + 8 * ((d >> 2) & 3) + 4 * (d >> 5) + (d & 3); }
    else if constexpr (MAP == 5) { const int c = n < FF ? n : n - FF; return 256 * (c >> 7) + (n < FF ? 0 : 128) + (c & 127); }
    else return n;
}
template <int MAP> __device__ __forceinline__ void tr_item(const float* __restrict__ W, int K, int N, const float* __restrict__ gain, bf16* WT, LAS float* scr, int item, int lane) {
    const int nblk = N / 64, kb = item / nblk, nb = item % nblk, k0 = 64 * kb, n0 = 64 * nb;
    const int lr = lane >> 4, lc = (lane & 15) * 4;
    f32x4 v[16];
#pragma unroll
    for (int i = 0; i < 16; ++i) v[i] = *(const f32x4*)(W + (size_t)(k0 + 4 * i + lr) * N + n0 + lc);
    if (gain) {
#pragma unroll
        for (int i = 0; i < 16; ++i) v[i] = v[i] * gain[k0 + 4 * i + lr]; }
#pragma unroll
    for (int i = 0; i < 16; ++i) { LAS float* d = scr + (4 * i + lr) * 65 + lc; d[0] = v[i].x; d[1] = v[i].y; d[2] = v[i].z; d[3] = v[i].w; }
    LDS_WAIT(); asm volatile("" ::: "memory");
    const int c = lane & 7;
#pragma unroll
    for (int j = 0; j < 8; ++j) { const int n = (lane >> 3) + 8 * j; const LAS float* s = scr + (8 * c) * 65 + n;
        v4u o; o.x = pk2(s[0 * 65], s[1 * 65]); o.y = pk2(s[2 * 65], s[3 * 65]); o.z = pk2(s[4 * 65], s[5 * 65]); o.w = pk2(s[6 * 65], s[7 * 65]);
        *(v4u*)(WT + (size_t)dst_row<MAP>(n0 + n) * K + k0 + 8 * c) = o; }
    LDS_WAIT(); asm volatile("" ::: "memory");
}
__device__ __forceinline__ void rms_row_to_bf16(const float* xrow, bf16* orow, int lane) {
    const f32x4* xr = (const f32x4*)xrow + lane; f32x4 v[8]; float s = 0.f;
#pragma unroll
    for (int j = 0; j < 8; ++j) { v[j] = xr[64 * j]; s += (v[j].x * v[j].x + v[j].y * v[j].y) + (v[j].z * v[j].z + v[j].w * v[j].w); }
    const float rs = 1.0f / sqrtf(wave_sum(s) * (1.f / DM) + EPS);
    unsigned long long* o8 = (unsigned long long*)orow + lane;
#pragma unroll
    for (int j = 0; j < 8; ++j) o8[64 * j] = (unsigned long long)pk2(v[j].x * rs, v[j].y * rs) | ((unsigned long long)pk2(v[j].z * rs, v[j].w * rs) << 32);
}

__device__ __forceinline__ int opqv(int v) { asm volatile("" : "+v"(v)); return v; }
__device__ __forceinline__ int opaque(int v) { asm volatile("" : "+s"(v)); return v; }
struct Args { const float* in[16]; float* out; unsigned char* ws; };
#define KARG(k) (((void* const*)__builtin_amdgcn_kernarg_segment_ptr())[opaque(k)])
#define IN(k) ((const float*)KARG(k))
#define OUTP ((float*)KARG(16))
#define WSP ((unsigned char*)KARG(17))

struct DealDil {
    const bf16* QKV; bf16* OG; float* LSE; const bf16* OM; const float* LM; int dil, nqb, G, c;
    __device__ __forceinline__ bool get(int i, att::BlockRef& b) const {
        const int L = c + i * G; if (L >= 1024) return false;
        const int qb = L % nqb, t = L / nqb, h = t & 15, r = t >> 4; const size_t tok0 = (size_t)r + (size_t)dil * 256 * qb;
        b.Q = QKV + tok0 * NQG + h * 128; b.K = QKV + (size_t)r * NQG + 2048 + h * 128; b.V = QKV + (size_t)r * NQG + 4096 + h * 128;
        b.O = OG + tok0 * DM + h * 128; b.Qpe = nullptr; b.Kpe = nullptr; b.LSE = LSE + tok0 * 16 + h; b.Om = OM + tok0 * DM + h * 128; b.Lm = LM + tok0 * 16 + h; b.P0 = qb * 256; b.pad = 0; return true;
    }
};
struct DealMla {
    const bf16* Q; const bf16* KV; const bf16* KPE; bf16* O; int G, c;
    __device__ __forceinline__ bool get(int i, att::BlockRef& b) const {
        int h, y;
        if (G == 256) { if (i >= 4) return false; h = (c & 7) + 8 * (i >> 1); y = c >> 3; }
        else { const int item = c + (i >> 1) * G; if (item >= 512) return false; h = item >> 5; y = item & 31; }
        const int qb = (i & 1) ? y : 63 - y;
        b.Q = Q + (size_t)qb * 256 * 3072 + h * 128; b.Qpe = Q + (size_t)qb * 256 * 3072 + 2048 + h * 64; b.K = KV + h * 256; b.V = KV + h * 256 + 128; b.Kpe = KPE;
        b.O = O + (size_t)qb * 256 * DM + h * 128; b.LSE = nullptr; b.Om = nullptr; b.Lm = nullptr; b.P0 = qb * 256; b.pad = 0; return true;
    }
};

#ifndef PHMASK
#define PHMASK 0xffff
#endif
#define PH(k) ((PHMASK >> (k)) & 1)
#ifndef REP_P0
#define REP_P0 1
#endif
#ifndef REP_ATT0
#define REP_ATT0 1
#endif
#ifndef REP_MLA
#define REP_MLA 1
#endif
#ifndef REP_GU
#define REP_GU 1
#endif
#ifndef REP_QKV
#define REP_QKV 1
#endif
#ifndef REP_L1P
#define REP_L1P 1
#endif
#ifndef EXTRA_SYNCS
#define EXTRA_SYNCS 0
#endif
__global__ void __launch_bounds__(512, 2) mk_fwd(Args a) {
    extern __shared__ __attribute__((aligned(16))) unsigned char lds[];
    cg::grid_group grid = cg::this_grid();
    const int wave = __builtin_amdgcn_readfirstlane((int)threadIdx.x >> 6);
#define lane opqv(mk_lane())
#define tid (wave * 64 + opqv(mk_lane()))
    const int G = gridDim.x, bx = blockIdx.x, gw = bx * 8 + wave, NGW = G * 8;
    LAS unsigned char* ldsl = (LAS unsigned char*)lds;
    volatile LAS unsigned* MISC = (volatile LAS unsigned*)(ldsl + LDS_TOTAL - 128);
    { const int t_ = tid; if (t_ < 32) MISC[t_] = 0u;
      if (bx == 0) { unsigned* bw = (unsigned*)(WSP + WS_BAR); for (int i = t_; i < XCD_BAR_WORDS; i += 512) bw[i] = 0u; } }
    __syncthreads();
#define GBAR() do { XcdBarrier b_; b_.bar = (unsigned*)(WSP + WS_BAR); b_.x = xb_xcc_id(); b_.st = MISC + 8; xcd_barrier(b_, wave == 0 && mk_lane() == 0); } while (0)
    grid.sync();
    (void)xcd_barrier_post((unsigned*)(WSP + WS_BAR), MISC + 8, wave == 0 && mk_lane() == 0);

#if PH(0)
    for (int rep_ = 0; rep_ < REP_P0; ++rep_) {
        LAS float* scr = (LAS float*)(ldsl + wave * 16640); unsigned char* ws = WSP;
        bf16* Wqkv = (bf16*)(ws + WS_WQKV); bf16* Woa = (bf16*)(ws + WS_WOA); bf16* Wa = (bf16*)(ws + WS_WA); bf16* Wkvb = (bf16*)(ws + WS_WKVB);
        bf16* Wqb = (bf16*)(ws + WS_WQB); bf16* Wob = (bf16*)(ws + WS_WOB); bf16* Wgu = (bf16*)(ws + WS_WGU); bf16* Wdn = (bf16*)(ws + WS_WDN);
        float* cosA = (float*)(ws + WS_COSA); float* sinA = (float*)(ws + WS_SINA); float* cosB = (float*)(ws + WS_COSB); float* sinB = (float*)(ws + WS_SINB);
        constexpr int I_QKV = 32 * 288, I_O = 32 * 32, I_KVA = 32 * 9, I_QA = 32 * 8, I_KVB = 8 * 64, I_QB = 8 * 48, I_GU = 32 * 176, I_DN = 88 * 32;
        constexpr int NITEMS = I_QKV + 2 * I_O + I_KVA + I_QA + I_KVB + I_QB + 2 * I_GU + 2 * I_DN;
        for (int it = gw; it < NITEMS; it += NGW) {
            int r = it;
            if (r < I_QKV) { tr_item<1>(IN(3), DM, 18432, IN(1), Wqkv, scr, r, lane); continue; } r -= I_QKV;
            if (r < I_O) { tr_item<0>(IN(4), DM, DM, nullptr, Woa, scr, r, lane); continue; } r -= I_O;
            if (r < I_KVA) { tr_item<2>(IN(6), DM, 576, IN(5), Wa, scr, r, lane); continue; } r -= I_KVA;
            if (r < I_QA) { tr_item<3>(IN(9), DM, 512, IN(1) + DM, Wa, scr, r, lane); continue; } r -= I_QA;
            if (r < I_KVB) { tr_item<0>(IN(8), 512, 4096, IN(7), Wkvb, scr, r, lane); continue; } r -= I_KVB;
            if (r < I_QB) { tr_item<4>(IN(11), 512, 3072, IN(10), Wqb, scr, r, lane); continue; } r -= I_QB;
            if (r < I_O) { tr_item<0>(IN(12), DM, DM, nullptr, Wob, scr, r, lane); continue; } r -= I_O;
            if (r < I_GU) { tr_item<5>(IN(13), DM, 2 * FF, IN(2), Wgu, scr, r, lane); continue; } r -= I_GU;
            if (r < I_GU) { tr_item<5>(IN(13) + (size_t)DM * 2 * FF, DM, 2 * FF, IN(2) + DM, Wgu + (size_t)2 * FF * DM, scr, r, lane); continue; } r -= I_GU;
            if (r < I_DN) { tr_item<0>(IN(14), FF, DM, nullptr, Wdn, scr, r, lane); continue; } r -= I_DN;
            tr_item<0>(IN(14) + (size_t)FF * DM, FF, DM, nullptr, Wdn + (size_t)DM * FF, scr, r, lane);
        }
        { v4u z = {0u, 0u, 0u, 0u}; v4u* p = (v4u*)(Wa + (size_t)1088 * DM); const int n16 = 192 * DM * 2 / 16;
          for (int i = bx * 512 + tid; i < n16; i += G * 512) p[i] = z; }
        { float* q = (float*)(ws + WS_SSQ); for (int i = bx * 512 + tid; i < 6 * S_; i += G * 512) q[i] = 0.f; }
        { const int i0 = bx * 512 + tid; const float inv = powf(500000.0f, -(float)(2 * (i0 & 15)) / 32.0f);
          for (int i = i0; i < S_ * 16; i += G * 512) { const float ang = (float)(i >> 4) * inv; cosA[i] = cosf(ang); sinA[i] = sinf(ang); } }
        { const int i0 = bx * 512 + tid; const float inv = powf(500000.0f, -(float)(2 * (i0 & 31)) / 64.0f);
          for (int i = i0; i < S_ * 32; i += G * 512) { const float ang = (float)(i >> 5) * inv; cosB[i] = cosf(ang); sinB[i] = sinf(ang); } }
        { const float* x = IN(0); bf16* XN = (bf16*)(ws + WS_XN); for (int m = gw; m < S_; m += NGW) rms_row_to_bf16(x + (size_t)m * DM, XN + (size_t)m * DM, lane); }
    }
#endif
    GBAR();

    for (int g = 0; g < 3; ++g) {
#if PH(1)
        for (int rep_ = 0; rep_ < REP_QKV; ++rep_) {
            unsigned char* ws = WSP; bf16* QKVG = (bf16*)(ws + WS_BIG + BIG_QKVG);
            pg8::Gemm gm{(const bf16*)(ws + WS_XN), (const bf16*)(ws + WS_WQKV) + (size_t)g * NQG * DM, S_, NQG, opaque(DM)}; pg8::StaticOrder So; So.init(S_, NQG, G, bx);
            epi::EpiQKV E{QKVG, (const float*)(ws + WS_COSA), (const float*)(ws + WS_SINA)};
            pg8::gemm_phase<epi::EpiQKV, pg8::StaticOrder, true, true>(ldsl, gm, So, E, wave);
        }
#endif
        GBAR();
#if PH(2)
        for (int rep_ = 0; rep_ < REP_ATT0; ++rep_) {
            unsigned char* ws = WSP; bf16* QKVG = (bf16*)(ws + WS_BIG + BIG_QKVG);
            const int dil = g == 0 ? 1 : (g == 1 ? 4 : 16);
            bf16* OG = g == 2 ? (bf16*)(ws + WS_XN) : (bf16*)OUTP + (size_t)g * S_ * DM;
            DealDil dl{QKVG, OG, (float*)(ws + WS_LSE) + (size_t)g * S_ * 16, (const bf16*)OUTP, (const float*)(ws + WS_LSE), dil, (S_ / dil) / 256, G, bx};
            const att::Pitch pt{dil * NQG, dil * NQG, dil * NQG, dil * DM, dil * 16, S_ * DM, S_ * 16};
            if (g < 2) att::attn_phase<false, true, true, false, DealDil>((char*)lds, dl, S_ / dil, 129, pt, 0.08838834764831845f, wave);
            else att::attn_phase<false, true, false, true, DealDil>((char*)lds, dl, S_ / dil, 129, pt, 0.08838834764831845f, wave);
        }
#endif
        GBAR();
    }
#if PH(4)
    {
        unsigned char* ws = WSP;
        pg8::Gemm gm{(const bf16*)(ws + WS_XN), (const bf16*)(ws + WS_WOA), S_, DM, opaque(DM)}; pg8::StaticOrder So; So.init(S_, DM, G, bx);
        epi::EpiResid<true, false, true> E{IN(0), (bf16*)(ws + WS_BIG + BIG_HB), (float*)(ws + WS_SSQ)};
        pg8::gemm_phase<epi::EpiResid<true, false, true>, pg8::StaticOrder, true, true>(ldsl, gm, So, E, wave);
    }
#endif
    GBAR();
    for (int layer = 0; layer < 2; ++layer) {
        if (layer == 1) {
#define L1PTRS unsigned char* ws = WSP; unsigned char* BIG = ws + WS_BIG; bf16* XN = (bf16*)(ws + WS_XN); bf16* C = (bf16*)(BIG + BIG_C); bf16* CQ = (bf16*)(BIG + BIG_CQ); bf16* KPE = (bf16*)(BIG + BIG_KPE); bf16* KV = (bf16*)(BIG + BIG_KV); bf16* Q = (bf16*)(BIG + BIG_Q); const float* cosB = (const float*)(ws + WS_COSB); const float* sinB = (const float*)(ws + WS_SINB); float* rskv = (float*)(ws + WS_RSKV); float* rsq = (float*)(ws + WS_RSQ); (void)XN; (void)C; (void)CQ; (void)KPE; (void)KV; (void)Q; (void)cosB; (void)sinB; (void)rskv; (void)rsq;
#if PH(5)
            for (int rep_ = 0; rep_ < REP_L1P; ++rep_) {
                L1PTRS
                pg8::Gemm gm{(const bf16*)OUTP, (const bf16*)(ws + WS_WA), S_, 1280, opaque(DM)}; pg8::StaticOrder So; So.init(S_, 1280, G, bx);
                epi::EpiA E{C, CQ, KPE, cosB, sinB, (const float*)(ws + WS_SSQ) + S_, (float*)(ws + WS_SSQ) + 3 * S_, (float*)(ws + WS_SSQ) + 4 * S_};
                pg8::gemm_phase<epi::EpiA, pg8::StaticOrder, true, true>(ldsl, gm, So, E, wave);
            }
#endif
            GBAR();
#if PH(7)
            for (int rep_ = 0; rep_ < REP_L1P; ++rep_) {
                L1PTRS
                pg8::Gemm gm{C, (const bf16*)(ws + WS_WKVB), S_, 4096, opaque(512)}; pg8::StaticOrder So; So.init(S_, 4096, G, bx);
                epi::EpiRowScale E{KV, 4096, (const float*)(ws + WS_SSQ) + 3 * S_, 1 << 30, cosB, sinB, 1.0f};
                pg8::gemm_phase<epi::EpiRowScale, pg8::StaticOrder, true, true>(ldsl, gm, So, E, wave);
            }
            {
                L1PTRS
                pg8::Gemm gm{CQ, (const bf16*)(ws + WS_WQB), S_, 3072, opaque(512)}; pg8::StaticOrder So; So.init(S_, 3072, G, bx);
                epi::EpiRowScale E{Q, 3072, (const float*)(ws + WS_SSQ) + 4 * S_, 2048, cosB, sinB, 0.07216878364870323f * 1.4426950408889634f};
                pg8::gemm_phase<epi::EpiRowScale, pg8::StaticOrder, true, true>(ldsl, gm, So, E, wave);
            }
#endif
            GBAR();
#if PH(8)
            for (int rep_ = 0; rep_ < REP_MLA; ++rep_) {
                L1PTRS
                DealMla dl{Q, KV, KPE, XN, G, bx};
                const att::Pitch pt{3072, 4096, 4096, DM, 0, 0, 0};
                att::attn_phase<true, false, false, false, DealMla>((char*)lds, dl, S_, 1 << 24, pt, 0.07216878364870323f, wave);
            }
#endif
            GBAR();
#if PH(9)
            {
                L1PTRS
                pg8::Gemm gm{XN, (const bf16*)(ws + WS_WOB), S_, DM, opaque(DM)}; pg8::StaticOrder So; So.init(S_, DM, G, bx);
                epi::EpiResid<false, false, true> E{(const bf16*)OUTP, (bf16*)(BIG + BIG_HB), (float*)(ws + WS_SSQ) + 2 * S_};
                pg8::gemm_phase<epi::EpiResid<false, false, true>, pg8::StaticOrder, true, true>(ldsl, gm, So, E, wave);
            }
#endif
            GBAR();
        }
#if PH(10)
        for (int rep_ = 0; rep_ < REP_GU; ++rep_) {
            unsigned char* ws = WSP; bf16* H1 = (bf16*)(ws + WS_BIG + BIG_H1);
            pg8::Gemm gm{(const bf16*)(ws + WS_BIG + BIG_HB), (const bf16*)(ws + WS_WGU) + (size_t)layer * 2 * FF * DM, S_, 2 * FF, opaque(DM)}; pg8::StaticOrder So; So.init(S_, 2 * FF, G, bx);
            epi::EpiSwiGLU E{H1, (const float*)(ws + WS_SSQ) + (size_t)(2 * layer) * S_};
            pg8::gemm_phase<epi::EpiSwiGLU, pg8::StaticOrder, true, true>(ldsl, gm, So, E, wave);
        }
#endif
        GBAR();
#if PH(11)
        {
            unsigned char* ws = WSP; bf16* H1 = (bf16*)(ws + WS_BIG + BIG_H1); float* out = OUTP;
            pg8::Gemm gm{H1, (const bf16*)(ws + WS_WDN) + (size_t)layer * DM * FF, S_, DM, opaque(FF)}; pg8::StaticOrder So; So.init(S_, DM, G, bx);
            const bf16* hb = (const bf16*)(ws + WS_BIG + BIG_HB);
            if (layer == 0) { epi::EpiResid<false, false, true> E{hb, (bf16*)out, (float*)(ws + WS_SSQ) + S_};
                pg8::gemm_phase<epi::EpiResid<false, false, true>, pg8::StaticOrder, true, true>(ldsl, gm, So, E, wave); }
            else { epi::EpiResid<false, false, true> E{hb, (bf16*)(ws + WS_XN), (float*)(ws + WS_SSQ) + 5 * S_};
                pg8::gemm_phase<epi::EpiResid<false, false, true>, pg8::StaticOrder, true, true>(ldsl, gm, So, E, wave); }
        }
#endif
        GBAR();
    }
    for (int rep_ = 0; rep_ < EXTRA_SYNCS; ++rep_) GBAR();
#if PH(12)
    {
        const float* gn = IN(15); float* out = OUTP; const bf16* hx = (const bf16*)(WSP + WS_XN); const float* sq = (const float*)(WSP + WS_SSQ) + 5 * S_;
        for (int m = gw; m < S_; m += NGW) { const int ln = lane; const float rs = 1.0f / sqrtf(sq[m + opqv(0)] * (1.f / DM) + EPS);
#pragma unroll
            for (int j = 0; j < 4; ++j) { const int c8 = (j * 64 + ln) * 8; const v4u w = *(const v4u*)(hx + (size_t)m * DM + c8);
                const f32x4 g0 = *(const f32x4*)(gn + c8), g1 = *(const f32x4*)(gn + c8 + 4);
                f32x4 o0 = {bflo(w[0]), bfhi(w[0]), bflo(w[1]), bfhi(w[1])}, o1 = {bflo(w[2]), bfhi(w[2]), bflo(w[3]), bfhi(w[3])};
                *(f32x4*)(out + (size_t)m * DM + c8) = o0 * rs * g0; *(f32x4*)(out + (size_t)m * DM + c8 + 4) = o1 * rs * g1; } }
    }
#endif
#undef GBAR
#undef lane
#undef tid
}

extern "C" void kernel_launch(void* const* d_in, const int* in_sizes, int n_in, void* d_out, int out_size, void* d_ws, size_t ws_size, hipStream_t stream) {
    static int grid = 0;
    if (grid == 0) {
        if (n_in != 16 || in_sizes[0] != S_ * DM || out_size != S_ * DM || ws_size < WS_END) { fprintf(stderr, "kernel_launch: unexpected shapes (n_in %d, ws %zu, need %zu)\n", n_in, ws_size, (size_t)WS_END); grid = -1; return; }
        int dev = 0, cus = 0, per_cu = 0;
        if (hipGetDevice(&dev) != hipSuccess || hipDeviceGetAttribute(&cus, hipDeviceAttributeMultiprocessorCount, dev) != hipSuccess) { grid = -1; return; }
        if (hipFuncSetAttribute((const void*)mk_fwd, hipFuncAttributeMaxDynamicSharedMemorySize, LDS_TOTAL) != hipSuccess) { fprintf(stderr, "kernel_launch: hipFuncSetAttribute failed\n"); grid = -1; return; }
        if (hipOccupancyMaxActiveBlocksPerMultiprocessor(&per_cu, (const void*)mk_fwd, 512, LDS_TOTAL) != hipSuccess || per_cu < 1) { fprintf(stderr, "kernel_launch: occupancy query says %d\n", per_cu); per_cu = 1; }
        (void)hipGetLastError();
        grid = cus;
    }
    if (grid < 0) return;
    Args a{};
    for (int i = 0; i < 16; ++i) a.in[i] = (const float*)d_in[i];
    a.out = (float*)d_out; a.ws = (unsigned char*)d_ws;
    void* args[] = {&a};
    hipError_t e = hipLaunchCooperativeKernel((const void*)mk_fwd, dim3(grid), dim3(512), args, LDS_TOTAL, stream);
    if (e != hipSuccess) fprintf(stderr, "kernel_launch: cooperative launch failed: %s (grid %d)\n", hipGetErrorString(e), grid);
}
```

```cpp
#include <hip/hip_runtime.h>
#include <hip/hip_cooperative_groups.h>
#include <cstdio>
#include <cstdint>
#include <cmath>
namespace cg = cooperative_groups;
__device__ __forceinline__ int mk_lane() { unsigned z = 0u; asm volatile("" : "+s"(z)); return (int)__builtin_amdgcn_mbcnt_hi(~0u, __builtin_amdgcn_mbcnt_lo(~0u, z)); }
namespace pg8 {
#define PG8_LAS __attribute__((address_space(3)))
typedef unsigned short bf16_t;
typedef short bf16x8 __attribute__((ext_vector_type(8)));
typedef float f32x4 __attribute__((ext_vector_type(4)));
typedef unsigned u32x4 __attribute__((ext_vector_type(4)));
constexpr int BM = 256, BK = 64, HALF = 128, HTB = HALF * BK * 2  , STAGE_BYTES = 8 * HTB, NXCD = 8, WGM = 8;

__host__ __device__ __forceinline__ int lds_byte(int r, int c) { const int st = (r >> 4) * 2 + (c >> 5), rr = r & 15, cc = c & 31, ob = rr * 64 + cc * 2; return st * 1024 + (ob ^ (((ob >> 9) & 1) << 5)); }
__host__ __device__ __forceinline__ void stage_rc(int b, int& R, int& C) { const int st = b / 1024, sb = b % 1024, swz = sb ^ (((sb >> 9) & 1) << 5); R = (st >> 1) * 16 + swz / 64; C = (st & 1) * 32 + (swz % 64) / 2; }
__host__ __device__ __forceinline__ int perm32(int rho) { const int n = rho >> 4, i = rho & 15; return 8 * (i >> 2) + 4 * n + (i & 3); }

struct Unit { int pm, pn; };
struct Gemm { const bf16_t* A; const bf16_t* Bt; int M, N, K; };

struct StaticOrder {
    int nM, nN, nwg, G, c;
    __host__ __device__ void init(int M, int N, int G_, int c_) { nM = M / BM; nN = N / BM; nwg = nM * nN; G = G_; c = c_; }
    __host__ __device__ bool next(int i, Unit& u) const {
        const long L = (long)i * G + c; if (L >= nwg) return false;
        int wgid = (int)L; { const int q = nwg / NXCD, r = nwg % NXCD, xcd = wgid % NXCD, off = wgid / NXCD; wgid = (xcd < r ? xcd * (q + 1) : r * (q + 1) + (xcd - r) * q) + off; }
        const int nig = WGM * nN, gid = wgid / nig, fm = gid * WGM, gsz = (nM - fm) < WGM ? (nM - fm) : WGM;
        u.pm = fm + ((wgid % nig) % gsz); u.pn = (wgid % nig) / gsz; return true;
    }
    __device__ __forceinline__ void a_ready(const Unit&) const {}
    __device__ __forceinline__ void done(const Unit&) const {}
};
__device__ __forceinline__ unsigned cvt_pk_bf16(float lo, float hi) { unsigned r; asm volatile("v_cvt_pk_bf16_f32 %0, %1, %2" : "=v"(r) : "v"(lo), "v"(hi)); return r; }
typedef float f32x2 __attribute__((ext_vector_type(2)));
template <class Epi, class Sched, bool ALIGN_EPI = false, bool SP2 = false>
__device__ __forceinline__ void gemm_phase(PG8_LAS unsigned char* lds, const Gemm g, const Sched& S, const Epi& E, const int wave_) {
    int tid_ = wave_ * 64 + mk_lane(); asm volatile("" : "+v"(tid_));
    const int tid = tid_, wid = __builtin_amdgcn_readfirstlane(tid >> 6), lane = tid & 63, wr = wid >> 2, wc = wid & 3, fr = lane & 15, fq = lane >> 4;
    const int K = g.K, nt = K / BK;
    unsigned voffA[2], voffB[2];
#pragma unroll
    for (int i = 0; i < 2; ++i) { int R, C; stage_rc(tid * 16 + i * 8192, R, C); const int Rb = Epi::PERM ? ((R & ~31) + perm32(R & 31)) : R;
        voffA[i] = (unsigned)(R * K + C) * 2u; voffB[i] = (unsigned)(Rb * K + C) * 2u; }
    const size_t kstep = (size_t)(BK * 2);
    const size_t hstep = (size_t)HALF * K * 2;
    const size_t tstep = 2 * hstep;
    const unsigned ldsw = (unsigned)wid * 1024u;
    const int aoff = lds_byte(wr * 64 + fr, fq * 8), boff = lds_byte(wc * 32 + fr, fq * 8);
#define PG8_SA(b, h) (((b) * 2 + (h)) * HTB)
#define PG8_SB(b, h) ((4 + (b) * 2 + (h)) * HTB)
#define PG8_STAGE(bufoff, gbase, voff) do { _Pragma("unroll") for (int _i = 0; _i < 2; ++_i) \
        __builtin_amdgcn_global_load_lds((const unsigned*)((const char*)(gbase) + (voff)[_i]), (PG8_LAS unsigned*)(lds + (bufoff) + ldsw + _i * 8192), 16, 0, 0); } while (0)
#define PG8_LDA(dst, b, h) do { _Pragma("unroll") for (int m = 0; m < 4; ++m) _Pragma("unroll") for (int k = 0; k < 2; ++k) dst[m][k] = *(const PG8_LAS bf16x8*)(lds + PG8_SA(b, h) + aoff + m * 2048 + k * 1024); } while (0)
#define PG8_LDB(dst, b, h) do { _Pragma("unroll") for (int n = 0; n < 2; ++n) _Pragma("unroll") for (int k = 0; k < 2; ++k) dst[n][k] = *(const PG8_LAS bf16x8*)(lds + PG8_SB(b, h) + boff + n * 2048 + k * 1024); } while (0)
#define PG8_MMA(ai, bj, At, Bt) do { __builtin_amdgcn_s_setprio(1); _Pragma("unroll") for (int m = 0; m < 4; ++m) _Pragma("unroll") for (int n = 0; n < 2; ++n) _Pragma("unroll") for (int k = 0; k < 2; ++k) \
        acc[ai][bj][m][n] = __builtin_amdgcn_mfma_f32_16x16x32_bf16(Bt[n][k], At[m][k], acc[ai][bj][m][n], 0, 0, 0); __builtin_amdgcn_s_setprio(0); } while (0)
#define PG8_WAIT_V(n) asm volatile("s_waitcnt vmcnt(" #n ")" ::: "memory")
#define PG8_WAIT_L(n) asm volatile("s_waitcnt lgkmcnt(" #n ")" ::: "memory")
#define PG8_BAR __builtin_amdgcn_s_barrier()
#define PG8_SCHED __builtin_amdgcn_sched_barrier(0)
    Unit cur, nxt; int ui = 0;
    if (!S.next(0, cur)) return;
    f32x4 acc[2][2][4][2];
#pragma unroll
    for (int a = 0; a < 2; ++a)
#pragma unroll
        for (int b = 0; b < 2; ++b)
#pragma unroll
            for (int m = 0; m < 4; ++m)
#pragma unroll
                for (int n = 0; n < 2; ++n) acc[a][b][m][n] = (f32x4){0.f, 0.f, 0.f, 0.f};
    bf16x8 At[4][2], B0[2][2], B1[2][2];
    const char* cA = (const char*)g.A + (size_t)cur.pm * tstep; const char* cB = (const char*)g.Bt + (size_t)cur.pn * tstep;
    S.a_ready(cur);
    if constexpr (SP2) {
        PG8_STAGE(PG8_SB(0, 0), cB, voffB); PG8_STAGE(PG8_SB(0, 1), cB + hstep, voffB); PG8_STAGE(PG8_SA(0, 0), cA, voffA); PG8_STAGE(PG8_SA(0, 1), cA + hstep, voffA);
        if (wr == 1) PG8_BAR;
        PG8_WAIT_V(2); PG8_BAR;
        PG8_STAGE(PG8_SB(1, 0), cB + kstep, voffB); PG8_STAGE(PG8_SA(1, 0), cA + kstep, voffA); PG8_STAGE(PG8_SB(1, 1), cB + hstep + kstep, voffB);
        PG8_WAIT_V(6); PG8_BAR;
    } else {
        PG8_STAGE(PG8_SB(0, 0), cB, voffB); PG8_STAGE(PG8_SA(0, 0), cA, voffA); PG8_STAGE(PG8_SB(0, 1), cB + hstep, voffB); PG8_STAGE(PG8_SA(0, 1), cA + hstep, voffA);
        if (wr == 1) PG8_BAR;
        PG8_WAIT_V(4); PG8_BAR;
        PG8_STAGE(PG8_SB(1, 0), cB + kstep, voffB); PG8_STAGE(PG8_SA(1, 0), cA + kstep, voffA); PG8_STAGE(PG8_SB(1, 1), cB + hstep + kstep, voffB);
        PG8_WAIT_V(6); PG8_BAR;
    }
    for (;;) {
        const bool has_next = S.next(ui + 1, nxt);
        const char* nA = has_next ? (const char*)g.A + (size_t)nxt.pm * tstep : cA; const char* nB = has_next ? (const char*)g.Bt + (size_t)nxt.pn * tstep : cB;
        for (int t = 0; t < nt; t += 2) {
            const bool last = (t == nt - 2);
            const char* a1 = cA + (size_t)(t + 1) * kstep;
            const char* a2 = last ? nA : cA + (size_t)(t + 2) * kstep; const char* b2 = last ? nB : cB + (size_t)(t + 2) * kstep;
            const char* a3 = a2 + kstep; const char* b3 = b2 + kstep;
            if (last && has_next) S.a_ready(nxt);
            if constexpr (SP2) {
            PG8_LDB(B0, 0, 0); PG8_LDB(B1, 0, 1); PG8_SCHED; PG8_LDA(At, 0, 0); PG8_STAGE(PG8_SA(1, 1), a1 + hstep, voffA);
            PG8_WAIT_V(8); PG8_WAIT_L(0); PG8_BAR; PG8_MMA(0, 0, At, B0); PG8_MMA(0, 1, At, B1); PG8_BAR; PG8_SCHED;
            PG8_LDA(At, 0, 1); PG8_STAGE(PG8_SB(0, 0), b2, voffB); PG8_STAGE(PG8_SB(0, 1), b2 + hstep, voffB); PG8_STAGE(PG8_SA(0, 0), a2, voffA);
            PG8_WAIT_V(8); PG8_WAIT_L(0); PG8_BAR; PG8_MMA(1, 0, At, B0); PG8_MMA(1, 1, At, B1); PG8_BAR; PG8_SCHED;
            PG8_LDB(B0, 1, 0); PG8_LDB(B1, 1, 1); PG8_SCHED; PG8_LDA(At, 1, 0); PG8_STAGE(PG8_SA(0, 1), a2 + hstep, voffA);
            PG8_WAIT_V(8); PG8_WAIT_L(0); PG8_BAR; PG8_MMA(0, 0, At, B0); PG8_MMA(0, 1, At, B1); PG8_BAR; PG8_SCHED;
            PG8_LDA(At, 1, 1); PG8_STAGE(PG8_SB(1, 0), b3, voffB); PG8_STAGE(PG8_SB(1, 1), b3 + hstep, voffB); PG8_STAGE(PG8_SA(1, 0), a3, voffA);
            PG8_WAIT_V(8); PG8_WAIT_L(0); PG8_BAR; PG8_MMA(1, 0, At, B0); PG8_MMA(1, 1, At, B1); PG8_BAR; PG8_SCHED;
            } else {
            PG8_LDB(B0, 0, 0); PG8_SCHED; PG8_LDA(At, 0, 0); PG8_STAGE(PG8_SA(1, 1), a1 + hstep, voffA);
            PG8_WAIT_L(8); PG8_BAR; PG8_WAIT_L(0); PG8_MMA(0, 0, At, B0); PG8_BAR; PG8_SCHED;
            PG8_LDB(B1, 0, 1); PG8_STAGE(PG8_SB(0, 0), b2, voffB);
            PG8_BAR; PG8_WAIT_L(0); PG8_MMA(0, 1, At, B1); PG8_BAR;
            PG8_LDA(At, 0, 1); PG8_STAGE(PG8_SA(0, 0), a2, voffA);
            PG8_BAR; PG8_WAIT_L(0); PG8_MMA(1, 0, At, B0); PG8_BAR; PG8_SCHED;
            PG8_STAGE(PG8_SB(0, 1), b2 + hstep, voffB);
            PG8_WAIT_V(6); PG8_BAR; PG8_MMA(1, 1, At, B1); PG8_BAR;
            PG8_LDB(B0, 1, 0); PG8_SCHED; PG8_LDA(At, 1, 0); PG8_STAGE(PG8_SA(0, 1), a2 + hstep, voffA);
            PG8_WAIT_L(8); PG8_BAR; PG8_WAIT_L(0); PG8_MMA(0, 0, At, B0); PG8_BAR; PG8_SCHED;
            PG8_LDB(B1, 1, 1); PG8_STAGE(PG8_SB(1, 0), b3, voffB);
            PG8_BAR; PG8_WAIT_L(0); PG8_MMA(0, 1, At, B1); PG8_BAR;
            PG8_LDA(At, 1, 1); PG8_STAGE(PG8_SA(1, 0), a3, voffA);
            PG8_BAR; PG8_WAIT_L(0); PG8_MMA(1, 0, At, B0); PG8_BAR; PG8_SCHED;
            PG8_STAGE(PG8_SB(1, 1), b3 + hstep, voffB);
            PG8_WAIT_V(6); PG8_BAR; PG8_MMA(1, 1, At, B1); PG8_BAR;
            }
        }
        if constexpr (ALIGN_EPI) { if (wr == 0) PG8_BAR; }
        if constexpr (!Epi::AFTER_DRAIN) { E(acc, cur, wr, wc, fr, fq); S.done(cur); }
        if (!has_next) break;
#pragma unroll
        for (int a = 0; a < 2; ++a)
#pragma unroll
            for (int b = 0; b < 2; ++b)
#pragma unroll
                for (int m = 0; m < 4; ++m)
#pragma unroll
                    for (int n = 0; n < 2; ++n) acc[a][b][m][n] = (f32x4){0.f, 0.f, 0.f, 0.f};
        cur = nxt; cA = nA; cB = nB; ++ui;
        if constexpr (ALIGN_EPI) { if (wr == 1) PG8_BAR; }
    }
    PG8_WAIT_V(0);
    if constexpr (!ALIGN_EPI) { if (wr == 0) PG8_BAR; }
    PG8_BAR;
    if constexpr (Epi::AFTER_DRAIN) { E.fused(acc, cur, wr, wc, fr, fq, lds, wid, lane); S.done(cur); }
#undef PG8_SA
#undef PG8_SB
#undef PG8_STAGE
#undef PG8_LDA
#undef PG8_LDB
#undef PG8_MMA
#undef PG8_WAIT_V
#undef PG8_WAIT_L
#undef PG8_BAR
#undef PG8_SCHED
}
}

namespace epi {
using namespace pg8;
__device__ __forceinline__ u32x4 pack8(f32x4 a, f32x4 b) { u32x4 w; w.x = cvt_pk_bf16(a[0], a[1]); w.y = cvt_pk_bf16(a[2], a[3]); w.z = cvt_pk_bf16(b[0], b[1]); w.w = cvt_pk_bf16(b[2], b[3]); return w; }
#define EPI_ROWS_BEGIN int row = u.pm * BM + wr * 64 + fr; _Pragma("unroll") for (int ai = 0; ai < 2; ++ai) { _Pragma("unroll") for (int m = 0; m < 4; ++m) {
#define EPI_LOAD_RS(ssqp) float rs8_[8]; { const int r0_ = u.pm * BM + wr * 64 + fr; _Pragma("unroll") for (int k_ = 0; k_ < 8; ++k_) rs8_[k_] = (ssqp)[r0_ + (k_ & 3) * 16 + (k_ >> 2) * HALF]; \
    _Pragma("unroll") for (int k_ = 0; k_ < 8; ++k_) rs8_[k_] = __builtin_amdgcn_rsqf(rs8_[k_] * (1.f / 2048.f) + 1e-6f); }
#define EPI_RS (rs8_[ai * 4 + m])
#define EPI_ROWS_END row += 16; asm volatile("" : "+v"(row) :: "memory"); } row += HALF - 64; }

struct EpiQKV {
    static constexpr bool PERM = true, AFTER_DRAIN = false;
    bf16_t* O; const float* cs; const float* sn;
    __device__ __forceinline__ void operator()(const f32x4 (&acc)[2][2][4][2], const Unit& u, int wr, int wc, int fr, int fq) const {
        const int colt = u.pn * BM, col0 = colt + wc * 32 + 8 * fq;
        const bool rope = (colt < 4096) && (wc == 0);
        int row = u.pm * BM + wr * 64 + fr;
#pragma unroll
        for (int ai = 0; ai < 2; ++ai) {
            f32x4 c4[4], s4[4];
            if (rope) {
#pragma unroll
                for (int m = 0; m < 4; ++m) { const unsigned to = (unsigned)(((row + 16 * m) * 16 + 4 * fq) * 4); c4[m] = *(const f32x4*)((const char*)cs + to); s4[m] = *(const f32x4*)((const char*)sn + to); } }
#pragma unroll
            for (int m = 0; m < 4; ++m) { bf16_t* rowp = O + (size_t)(row + 16 * m) * 6144 + col0;
#pragma unroll
                for (int bj = 0; bj < 2; ++bj) { f32x4 v0 = acc[ai][bj][m][0], v1 = acc[ai][bj][m][1];
                    if (rope) { const f32x4 a = v0 * c4[m] - v1 * s4[m], b = v1 * c4[m] + v0 * s4[m]; v0 = a; v1 = b; }
                    *(u32x4*)(rowp + bj * HALF) = pack8(v0, v1); } }
            row += HALF; asm volatile("" : "+v"(row) :: "memory");
        }
    }
};
__device__ __forceinline__ f32x4 bf_lo4(unsigned a, unsigned b) { return (f32x4){__builtin_bit_cast(float, a << 16), __builtin_bit_cast(float, a & 0xffff0000u), __builtin_bit_cast(float, b << 16), __builtin_bit_cast(float, b & 0xffff0000u)}; }
template <bool BASE_F32, bool OUT_F32, bool STAT> struct EpiResid {
    static constexpr bool PERM = true, AFTER_DRAIN = false;
    const void* base; void* out; float* ssq;
    __device__ __forceinline__ void operator()(const f32x4 (&acc)[2][2][4][2], const Unit& u, int wr, int wc, int fr, int fq) const {
        const int col0 = u.pn * BM + wc * 32 + 8 * fq;
        int row = u.pm * BM + wr * 64 + fr;
#pragma unroll
        for (int ai = 0; ai < 2; ++ai) {
            f32x4 bf_[BASE_F32 ? 4 : 1][2][2]; u32x4 bh_[BASE_F32 ? 1 : 4][2];
#pragma unroll
            for (int m = 0; m < 4; ++m)
#pragma unroll
                for (int bj = 0; bj < 2; ++bj) { const unsigned off = (unsigned)((row + 16 * m) * 2048 + col0 + bj * HALF);
                    if constexpr (BASE_F32) { bf_[m][bj][0] = *(const f32x4*)((const float*)base + off); bf_[m][bj][1] = *(const f32x4*)((const float*)base + off + 4); }
                    else bh_[m][bj] = *(const u32x4*)((const bf16_t*)base + off); }
#pragma unroll
            for (int m = 0; m < 4; ++m) { float s = 0.f;
#pragma unroll
                for (int bj = 0; bj < 2; ++bj) { const unsigned off = (unsigned)((row + 16 * m) * 2048 + col0 + bj * HALF); f32x4 h0, h1;
                    if constexpr (BASE_F32) { h0 = bf_[m][bj][0] + acc[ai][bj][m][0]; h1 = bf_[m][bj][1] + acc[ai][bj][m][1]; }
                    else { h0 = bf_lo4(bh_[m][bj].x, bh_[m][bj].y) + acc[ai][bj][m][0]; h1 = bf_lo4(bh_[m][bj].z, bh_[m][bj].w) + acc[ai][bj][m][1]; }
                    if constexpr (OUT_F32) { *(f32x4*)((float*)out + off) = h0; *(f32x4*)((float*)out + off + 4) = h1; }
                    else *(u32x4*)((bf16_t*)out + off) = pack8(h0, h1);
                    if constexpr (STAT) { const f32x4 q4 = h0 * h0 + h1 * h1; s += (q4[0] + q4[1]) + (q4[2] + q4[3]); } }
                if constexpr (STAT) { s += __shfl_xor(s, 16); s += __shfl_xor(s, 32); if (fq == 0) atomicAdd(ssq + row + 16 * m, s); } }
            row += HALF; asm volatile("" : "+v"(row) :: "memory");
        }
    }
};
__device__ __forceinline__ float silu1(float x) { return x * __builtin_amdgcn_rcpf(1.f + __builtin_amdgcn_exp2f(-1.4426950408889634f * x)); }
struct EpiSwiGLU {
    static constexpr bool PERM = true, AFTER_DRAIN = false;
    bf16_t* O; const float* ssq;
    __device__ __forceinline__ void operator()(const f32x4 (&acc)[2][2][4][2], const Unit& u, int wr, int wc, int fr, int fq) const {
        const int col0 = u.pn * 128 + wc * 32 + 8 * fq;
        EPI_LOAD_RS(ssq)
        EPI_ROWS_BEGIN
            const float r = EPI_RS, rl = -1.4426950408889634f * r, r2 = r * r;
            f32x4 h[2];
#pragma unroll
            for (int n = 0; n < 2; ++n) { const f32x4 g = acc[ai][0][m][n], uu = acc[ai][1][m][n]; const f32x4 t = g * rl; f32x4 e;
#pragma unroll
                for (int j = 0; j < 4; ++j) e[j] = __builtin_amdgcn_exp2f(t[j]);
                const f32x4 d = e + 1.0f; f32x4 s;
#pragma unroll
                for (int j = 0; j < 4; ++j) s[j] = __builtin_amdgcn_rcpf(d[j]);
                h[n] = (g * uu) * (s * r2); }
            *(u32x4*)(O + (size_t)row * 5632 + col0) = pack8(h[0], h[1]);
        EPI_ROWS_END
    }
};
struct EpiA {
    static constexpr bool PERM = true, AFTER_DRAIN = false;
    bf16_t* C; bf16_t* CQ; bf16_t* KPE; const float* cs; const float* sn; const float* ssq; float* ssqC; float* ssqQ;
    __device__ __forceinline__ void operator()(const f32x4 (&acc)[2][2][4][2], const Unit& u, int wr, int wc, int fr, int fq) const {
        EPI_LOAD_RS(ssq)
        if (u.pn < 4) { bf16_t* dst = (u.pn < 2 ? C : CQ) + (u.pn & 1) * 256 + wc * 32 + 8 * fq;
            EPI_ROWS_BEGIN
                const float r = EPI_RS; float s = 0.f;
#pragma unroll
                for (int bj = 0; bj < 2; ++bj) { const f32x4 v0 = acc[ai][bj][m][0] * r, v1 = acc[ai][bj][m][1] * r;
                    s += ((v0[0] * v0[0] + v0[1] * v0[1]) + (v0[2] * v0[2] + v0[3] * v0[3])) + ((v1[0] * v1[0] + v1[1] * v1[1]) + (v1[2] * v1[2] + v1[3] * v1[3]));
                    *(u32x4*)((char*)dst + (unsigned)((row * 512 + bj * HALF) * 2)) = pack8(v0, v1); }
                s += __shfl_xor(s, 16); s += __shfl_xor(s, 32); if (fq == 0) atomicAdd((u.pn < 2 ? ssqC : ssqQ) + row, s);
            EPI_ROWS_END
        } else if (wc < 2) {
            EPI_ROWS_BEGIN
                const unsigned to = (unsigned)((row * 32 + 16 * wc + 4 * fq) * 4); const f32x4 c4 = *(const f32x4*)((const char*)cs + to), s4 = *(const f32x4*)((const char*)sn + to);
                const float r = EPI_RS;
                const f32x4 v0 = acc[ai][0][m][0] * r, v1 = acc[ai][0][m][1] * r;
                *(u32x4*)((char*)KPE + (unsigned)((row * 64 + 32 * wc + 8 * fq) * 2)) = pack8(v0 * c4 - v1 * s4, v1 * c4 + v0 * s4);
            EPI_ROWS_END
        }
    }
};
struct EpiRowScale {
    static constexpr bool PERM = true, AFTER_DRAIN = false;
    bf16_t* O; int ldc; const float* rs; int rope0; const float* cs; const float* sn; float mul;
    __device__ __forceinline__ void operator()(const f32x4 (&acc)[2][2][4][2], const Unit& u, int wr, int wc, int fr, int fq) const {
        const int colt = u.pn * BM, col0 = colt + wc * 32 + 8 * fq;
        const bool rope = colt >= rope0; const int w = wc & 1;
        int row = u.pm * BM + wr * 64 + fr;
        float r8[8];
#pragma unroll
        for (int k = 0; k < 8; ++k) r8[k] = rs[row + (k & 3) * 16 + (k >> 2) * HALF];
#pragma unroll
        for (int k = 0; k < 8; ++k) r8[k] = mul * __builtin_amdgcn_rsqf(r8[k] * (1.f / 512.f) + 1e-6f);
#pragma unroll
        for (int ai = 0; ai < 2; ++ai) {
            f32x4 c4[4], s4[4];
            if (rope) {
#pragma unroll
                for (int m = 0; m < 4; ++m) { const unsigned to = (unsigned)(((row + 16 * m) * 32 + 16 * w + 4 * fq) * 4); c4[m] = *(const f32x4*)((const char*)cs + to); s4[m] = *(const f32x4*)((const char*)sn + to); } }
#pragma unroll
            for (int m = 0; m < 4; ++m) { const float r = r8[ai * 4 + m];
#pragma unroll
                for (int bj = 0; bj < 2; ++bj) { f32x4 v0 = acc[ai][bj][m][0] * r, v1 = acc[ai][bj][m][1] * r;
                    if (rope) { const f32x4 a = v0 * c4[m] - v1 * s4[m], b = v1 * c4[m] + v0 * s4[m]; v0 = a; v1 = b; }
                    *(u32x4*)((char*)O + (unsigned)(((row + 16 * m) * ldc + col0 + bj * HALF) * 2)) = pack8(v0, v1); } }
            row += HALF; asm volatile("" : "+v"(row) :: "memory");
        }
    }
};
#undef EPI_ROWS_BEGIN
#undef EPI_ROWS_END
#undef EPI_LOAD_RS
#undef EPI_RS
}

namespace att {
typedef unsigned short bf16_t;
typedef short bf16x8 __attribute__((ext_vector_type(8)));
typedef short s16x4 __attribute__((ext_vector_type(4)));
typedef float f32x16 __attribute__((ext_vector_type(16)));
typedef float f32x4 __attribute__((ext_vector_type(4)));
typedef unsigned u32x4 __attribute__((ext_vector_type(4)));
constexpr int NW = 8, QBLK = 32, KVBLK = 64, QB = NW * QBLK, D = 128;
constexpr int SHM_V = KVBLK * D * 2, SHM_K = KVBLK * D * 2, SHM_K2 = KVBLK * 64 * 2;
constexpr int OFF_WS = 2 * SHM_V + 2 * SHM_K, OFF_K2 = OFF_WS + NW * 64 * 4, OFF_QPE = OFF_K2 + 2 * SHM_K2, LDS_BYTES = OFF_QPE + NW * 4096;
constexpr float THR = 8.f;
#define ALDS __attribute__((address_space(3)))
#define KSWZ(row, colB) ((row) * 256 + ((colB) ^ (((row) & 7) << 4)))
#define SBAR() __builtin_amdgcn_sched_barrier(0)
__device__ __forceinline__ int v_st(int k, int c) { const int kk = (k & ~0xC) | ((k & 4) << 1) | ((k & 8) >> 1); return ((kk >> 3) * 4 + (c >> 5)) * 512 + ((kk & 7) * 32 + (c & 31)) * 2; }
__device__ __forceinline__ int v_rd_base(int lane) { return ((lane & 3) << 3) | (((lane >> 2) & 3) << 6) | (((lane >> 4) & 1) << 5) | (((lane >> 5) & 1) << 8); }
constexpr int v_rd_off(int d0, int ks, int half) { return d0 * 512 + ks * 4096 + half * 2048; }
__device__ __forceinline__ int crow(int r, int hi) { return (r & 3) + 8 * (r >> 2) + 4 * hi; }
__device__ __forceinline__ unsigned cvtpk(float lo, float hi) {
    unsigned r; asm volatile("v_cvt_pk_bf16_f32 %0, %1, %2" : "=v"(r) : "v"(lo), "v"(hi)); return r;
}
__device__ __forceinline__ bf16x8 pack8(f32x4 a, f32x4 b) {
    u32x4 w = {cvtpk(a[0], a[1]), cvtpk(a[2], a[3]), cvtpk(b[0], b[1]), cvtpk(b[2], b[3])};
    return *reinterpret_cast<bf16x8*>(&w);
}
__device__ __forceinline__ bf16x8 load8(const bf16_t* p) { return *reinterpret_cast<const bf16x8*>(p); }
__device__ __forceinline__ void partialSM(f32x16& p0, f32x16& p1, float& m_reg, float& mn, float& alpha, const float SCALE) {
    float pmax = p0[0]; for (int r = 1; r < 16; ++r) pmax = fmaxf(pmax, p0[r]); for (int r = 0; r < 16; ++r) pmax = fmaxf(pmax, p1[r]);
    { auto rr = __builtin_amdgcn_permlane32_swap(__float_as_uint(pmax), __float_as_uint(pmax), false, false);
      pmax = fmaxf(__uint_as_float(rr[0]), __uint_as_float(rr[1])); }
    const float C2 = 1.4426950408889634f * SCALE;
    if (__builtin_expect(__all((pmax - m_reg) * SCALE <= THR), 1)) { mn = m_reg; alpha = 1.f; }
    else { mn = fmaxf(m_reg, pmax); alpha = __builtin_amdgcn_exp2f((m_reg - mn) * C2); m_reg = mn; }
    const float mnL = -mn * C2;
    for (int r = 0; r < 16; ++r) p0[r] = fmaf(p0[r], C2, mnL); for (int r = 0; r < 16; ++r) p1[r] = fmaf(p1[r], C2, mnL);
    for (int r = 0; r < 16; ++r) p0[r] = __builtin_amdgcn_exp2f(p0[r]);
}
__device__ __forceinline__ void partialSM2(f32x16& p0, f32x16& p1, float& mhat, f32x16& negm, float& alpha, const bool first_tile) {
    float pmax = p0[0]; for (int r = 1; r < 16; ++r) pmax = fmaxf(pmax, p0[r]); for (int r = 0; r < 16; ++r) pmax = fmaxf(pmax, p1[r]);
    { auto rr = __builtin_amdgcn_permlane32_swap(__float_as_uint(pmax), __float_as_uint(pmax), false, false);
      pmax = fmaxf(__uint_as_float(rr[0]), __uint_as_float(rr[1])); }
    constexpr float THR2 = THR * 1.4426950408889634f;
    alpha = 1.f;
    if (first_tile || !__all(pmax <= THR2)) { const float dl = first_tile ? pmax : fmaxf(pmax, 0.f); mhat += dl;
        for (int r = 0; r < 16; ++r) { p0[r] -= dl; p1[r] -= dl; }
        for (int r = 0; r < 16; ++r) negm[r] = -mhat;
        alpha = __builtin_amdgcn_exp2f(-dl); }
    for (int r = 0; r < 16; ++r) p0[r] = __builtin_amdgcn_exp2f(p0[r]);
}
template <int KB, bool SK, bool MLA>
__device__ __forceinline__ void qkt(f32x16& p0, f32x16& p1, ALDS const char* K_lds, ALDS const char* K2_lds, ALDS const char* Qpe_lds, int r32, int hi, const bf16x8* qr, bool act, const f32x16& cinit) {
    if (SK && !act) { const float NEG = -__builtin_inff();
#pragma unroll
        for (int r = 0; r < 16; ++r) { p0[r] = NEG; p1[r] = NEG; } return; }
    if constexpr (MLA) { p0 = cinit; p1 = cinit; } else { p0 = f32x16{}; p1 = f32x16{}; }
    ALDS const char* kb[4];
#pragma unroll
    for (int dd = 0; dd < 4; ++dd) kb[dd] = K_lds + KB * SHM_K + KSWZ(r32, (dd * 16 + hi * 8) * 2);
    ALDS const char* k2b = K2_lds + KB * SHM_K2 + r32 * 128; const int k2x = (r32 >> 1) & 7;
    constexpr int NS = MLA ? 12 : 8;
    bf16x8 fa[3], fb[3], fq[3];
#define QKT_LOAD(d0_, B) do {                                                                                                              \
        if ((d0_) < 8) { ALDS const char* a_ = kb[(d0_) & 3] + ((d0_) >> 2) * 128; fa[B] = *(ALDS const bf16x8*)(a_); fb[B] = *(ALDS const bf16x8*)(a_ + 32 * 256); }   \
        else { ALDS const char* a_ = k2b + (((((d0_) - 8) * 2 + hi) ^ k2x) << 4); fa[B] = *(ALDS const bf16x8*)(a_); fb[B] = *(ALDS const bf16x8*)(a_ + 32 * 128);     \
               fq[B] = *(ALDS const bf16x8*)(Qpe_lds + ((d0_) - 8) * 1024); } } while (0)
    QKT_LOAD(0, 0); QKT_LOAD(1, 1);
#pragma unroll
    for (int d0 = 0; d0 < NS; ++d0) {
        if (d0 + 2 < NS) { if ((d0 + 2) % 3 == 0) QKT_LOAD(d0 + 2, 0); else if ((d0 + 2) % 3 == 1) QKT_LOAD(d0 + 2, 1); else QKT_LOAD(d0 + 2, 2); }
        SBAR();
        { const bf16x8 q_ = d0 < 8 ? qr[d0 < 8 ? d0 : 0] : fq[d0 % 3];
          p0 = __builtin_amdgcn_mfma_f32_32x32x16_bf16(fa[d0 % 3], q_, p0, 0, 0, 0);
          p1 = __builtin_amdgcn_mfma_f32_32x32x16_bf16(fb[d0 % 3], q_, p1, 0, 0, 0); }
        SBAR();
    }
#undef QKT_LOAD
}
__device__ __forceinline__ void mask_tile(f32x16& p0, f32x16& p1, int dq, unsigned W) {
    const float NEG = -__builtin_inff();
#pragma unroll
    for (int r = 0; r < 16; ++r) {
        const int c = (r & 3) + 8 * (r >> 2);
        if ((unsigned)(dq - c) >= W) p0[r] = NEG;
        if ((unsigned)(dq - c - 32) >= W) p1[r] = NEG;
    }
}
__device__ __forceinline__ void finishSM(f32x16& p0, f32x16& p1, float alpha, float& l_reg, bf16x8& pa0, bf16x8& pa1, bf16x8& pa2, bf16x8& pa3) {
    for (int r = 0; r < 16; ++r) p1[r] = __builtin_amdgcn_exp2f(p1[r]);
    float ps = 0; for (int r = 0; r < 16; ++r) ps += p0[r]; for (int r = 0; r < 16; ++r) ps += p1[r];
    { auto rr = __builtin_amdgcn_permlane32_swap(__float_as_uint(ps), __float_as_uint(ps), false, false);
      ps = __uint_as_float(rr[0]) + __uint_as_float(rr[1]); }
    l_reg = l_reg * alpha + ps;
#define PK4(P, B_, OUT) do { unsigned a0 = cvtpk(P[B_+0], P[B_+1]), a1 = cvtpk(P[B_+2], P[B_+3]);                          \
        unsigned b0 = cvtpk(P[B_+4], P[B_+5]), b1 = cvtpk(P[B_+6], P[B_+7]);                                             \
        auto r0 = __builtin_amdgcn_permlane32_swap(a0, b0, false, false); auto r1 = __builtin_amdgcn_permlane32_swap(a1, b1, false, false); \
        u32x4 w = {r0[0], r1[0], r0[1], r1[1]}; OUT = *reinterpret_cast<bf16x8*>(&w); } while (0)
    PK4(p0, 0, pa0); PK4(p0, 8, pa1); PK4(p1, 0, pa2); PK4(p1, 8, pa3);
#undef PK4
}
template <int VB, bool SK>
__device__ __forceinline__ void pv_tile(f32x16* o, int vb0, bf16x8 pa0, bf16x8 pa1, bf16x8 pa2, bf16x8 pa3, bool act) {
    if (SK && !act) return;
    s16x4 L0[4], H0[4], L1[4], H1[4];
#define TRRD(dst, off) asm volatile("ds_read_b64_tr_b16 %0, %1 offset:%2" : "=&v"(dst) : "v"(vb0), "i"(off) : "memory")
#define PV_ISSUE(d0, L, H) do { constexpr int b_ = VB * SHM_V + v_rd_off(d0, 0, 0);     \
        TRRD(L[0], b_); TRRD(H[0], b_ + 2048); TRRD(L[1], b_ + 4096); TRRD(H[1], b_ + 6144); TRRD(L[2], b_ + 8192); TRRD(H[2], b_ + 10240); TRRD(L[3], b_ + 12288); TRRD(H[3], b_ + 14336); } while (0)
#define PV_MMA(d0, L, H) do { SBAR();                                                                                                   \
        o[d0] = __builtin_amdgcn_mfma_f32_32x32x16_bf16(pa0, (bf16x8){L[0][0], L[0][1], L[0][2], L[0][3], H[0][0], H[0][1], H[0][2], H[0][3]}, o[d0], 0, 0, 0);   \
        o[d0] = __builtin_amdgcn_mfma_f32_32x32x16_bf16(pa1, (bf16x8){L[1][0], L[1][1], L[1][2], L[1][3], H[1][0], H[1][1], H[1][2], H[1][3]}, o[d0], 0, 0, 0);   \
        o[d0] = __builtin_amdgcn_mfma_f32_32x32x16_bf16(pa2, (bf16x8){L[2][0], L[2][1], L[2][2], L[2][3], H[2][0], H[2][1], H[2][2], H[2][3]}, o[d0], 0, 0, 0);   \
        o[d0] = __builtin_amdgcn_mfma_f32_32x32x16_bf16(pa3, (bf16x8){L[3][0], L[3][1], L[3][2], L[3][3], H[3][0], H[3][1], H[3][2], H[3][3]}, o[d0], 0, 0, 0); SBAR(); } while (0)
    PV_ISSUE(0, L0, H0);
    PV_ISSUE(1, L1, H1); asm volatile("s_waitcnt lgkmcnt(8)" ::: "memory"); PV_MMA(0, L0, H0);
    PV_ISSUE(2, L0, H0); asm volatile("s_waitcnt lgkmcnt(8)" ::: "memory"); PV_MMA(1, L1, H1);
    PV_ISSUE(3, L1, H1); asm volatile("s_waitcnt lgkmcnt(8)" ::: "memory"); PV_MMA(2, L0, H0);
    asm volatile("s_waitcnt lgkmcnt(0)" ::: "memory"); PV_MMA(3, L1, H1);
#undef PV_ISSUE
#undef PV_MMA
#undef TRRD
}

struct Pitch { int qp, kp, vp, op, lp, mo, ml; };
struct BlockRef { const bf16_t* Q; const bf16_t* K; const bf16_t* V; bf16_t* O; const bf16_t* Qpe; const bf16_t* Kpe; float* LSE; const bf16_t* Om; const float* Lm; int P0; int pad; };
__device__ __forceinline__ int swa_jlo(int P0, int W) { const int lowk = P0 - W + 1; return lowk > 0 ? lowk / KVBLK : 0; }
#define ROWP(p, pitch, k0, rr) ((p) + (size_t)((k0) + (rr)) * (size_t)(pitch) + sc)
#define VMW() asm volatile("s_waitcnt vmcnt(0)" ::: "memory")
__device__ __forceinline__ void glds16(const void* gsrc, unsigned lds_dst) { unsigned keep;
    asm volatile("s_mov_b32 %0, m0\n\ts_mov_b32 m0, %2\n\ts_nop 0\n\tglobal_load_lds_dwordx4 %1, off\n\ts_mov_b32 m0, %0" : "=&s"(keep) : "v"(gsrc), "s"(lds_dst) : "memory"); }
#define DMA_TILE_P(Kp, Vp, Kpep, k0, bf) do { const char* vb_ = (const char*)((Vp) + (size_t)(k0) * (size_t)pt.vp); const char* kb_ = (const char*)((Kp) + (size_t)(k0) * (size_t)pt.kp);                   \
        glds16(vb_ + vof0, (unsigned)__builtin_amdgcn_readfirstlane(ldsV + (bf) * SHM_V)); glds16(vb_ + vof1, (unsigned)__builtin_amdgcn_readfirstlane(ldsV + (bf) * SHM_V + 8192));  \
        glds16(kb_ + kof0, (unsigned)__builtin_amdgcn_readfirstlane(ldsK + (bf) * SHM_K)); glds16(kb_ + kof1, (unsigned)__builtin_amdgcn_readfirstlane(ldsK + (bf) * SHM_K + 8192));  \
        if constexpr (MLA) glds16((const char*)((Kpep) + (size_t)(k0) * 64) + k2of, (unsigned)__builtin_amdgcn_readfirstlane(ldsK2 + (bf) * SHM_K2)); } while (0)
#define DMA_TILE(k0, bf) DMA_TILE_P(Kh, Vh, Kpeh, k0, bf)
#define Q_LOADS(B) do { _Pragma("unroll") for (int d0 = 0; d0 < 8; ++d0) qr[d0] = load8((B).Q + (size_t)(wid * QBLK + r32) * pt.qp + d0 * 16 + hi * 8);               \
        if constexpr (MLA) { _Pragma("unroll") for (int d0 = 0; d0 < 4; ++d0) qpe[d0] = load8((B).Qpe + (size_t)(wid * QBLK + r32) * pt.qp + d0 * 16 + hi * 8); } } while (0)
template <bool MLA, bool SK, bool LSEOUT, bool MERGE>
__device__ __forceinline__ void attn_block(const BlockRef& cur, const BlockRef& nxt, const bool has_next, const bool first, int skv, int W, char* lds, const Pitch& pt, const float SCALE, const int wave_, bf16x8 (&qr)[8], bf16x8 (&qpe)[4]) {
    int tid_ = wave_ * 64 + mk_lane(); asm volatile("" : "+v"(tid_));
    const int tid = tid_, wid = __builtin_amdgcn_readfirstlane(tid >> 6), lane = tid & 63, r32 = lane & 31, hi = lane >> 5;
    const int j_lo = swa_jlo(cur.P0, W);
    int j_hi = (cur.P0 + QB - 1) / KVBLK + 1; if (j_hi > skv / KVBLK) j_hi = skv / KVBLK;
    const int NT = j_hi - j_lo;
    const int qlo = cur.P0 + wid * QBLK, qm = qlo + r32 - 4 * hi;
    ALDS char* ldsa = (ALDS char*)lds; ALDS char* V_lds = ldsa; ALDS char* K_lds = ldsa + 2 * SHM_V; ALDS char* K2_lds = ldsa + OFF_K2; ALDS char* Qpe_lds = ldsa + OFF_QPE + wid * 4096 + lane * 16;
    ALDS float* ws = (ALDS float*)(ldsa + OFF_WS) + wid * 64; ALDS float* li_l = ws; ALDS float* al_l = ws + 32;
    float m_reg = -1e30f, l_reg = 0; f32x16 o[4] = {};
    const int krow = 4 * wid + (lane >> 4), kcol = ((lane & 15) ^ (krow & 7)) * 8;
    const int vkk = (wid >> 1) * 8 + ((lane >> 2) & 7), vkey = (vkk & ~0xC) | ((vkk & 4) << 1) | ((vkk & 8) >> 1), vcol = (wid & 1) * 64 + (lane >> 5) * 32 + (lane & 3) * 8;
    const int k2row = 8 * wid + (lane >> 3), k2col = ((lane & 7) ^ ((k2row >> 1) & 7)) * 8;
    const unsigned kof0 = (unsigned)((krow * pt.kp + kcol) * 2), kof1 = kof0 + (unsigned)(32 * pt.kp * 2), vof0 = (unsigned)((vkey * pt.vp + vcol) * 2), vof1 = vof0 + (unsigned)(32 * pt.vp * 2), k2of = (unsigned)((k2row * 64 + k2col) * 2);
    (void)k2of;
    const unsigned lds0 = (unsigned)(uintptr_t)lds; const unsigned ldsV = lds0 + wid * 1024, ldsK = lds0 + 2 * SHM_V + wid * 1024, ldsK2 = lds0 + OFF_K2 + wid * 1024; (void)ldsK2;
    const int vb0 = (int)(unsigned)(uintptr_t)V_lds + v_rd_base(lane);
    const bf16_t* Kh = cur.K; const bf16_t* Vh = cur.V; const bf16_t* Kpeh = cur.Kpe;
#define RESC(a) do { if (__any((a) < 1.f)) { if (hi == 0) al_l[r32] = (a); asm volatile("s_waitcnt lgkmcnt(0)" ::: "memory");              \
                     for (int d_ = 0; d_ < 4; ++d_) for (int r = 0; r < 16; ++r) o[d_][r] *= al_l[crow(r, hi)]; } } while (0)
#define KBASE(t) ((j_lo + (t)) * KVBLK)
#define ACT(t) (KBASE(t) <= qlo + QBLK - 1 && KBASE(t) + KVBLK - 1 >= qlo - W + 1)
#define MASKT(P0_, P1_, t) do { const int kb_ = KBASE(t); if ((!SK || ACT(t)) && (kb_ + KVBLK - 1 > qlo || kb_ <= qlo + QBLK - 1 - W)) mask_tile(P0_, P1_, qm - kb_, (unsigned)W); } while (0)
    if (first) { DMA_TILE(KBASE(0), 0); Q_LOADS(cur); }
    if constexpr (MLA) {
#pragma unroll
        for (int d0 = 0; d0 < 4; ++d0) *(ALDS bf16x8*)(Qpe_lds + d0 * 1024) = qpe[d0]; }
    VMW();
    __syncthreads();
    bf16x8 pa0, pa1, pa2, pa3;
    f32x16 negm = {}; float mhat = 0.f; (void)mhat;
#define STEP(t, B) do { f32x16 p0_, p1_; float mn_, al_;                                                                       \
        if ((t) + 1 < NT) { DMA_TILE(KBASE((t) + 1), 1 - B); } SBAR();                                                        \
        qkt<B, SK, MLA>(p0_, p1_, K_lds, K2_lds, Qpe_lds, r32, hi, qr, ACT(t), negm);                                         \
        MASKT(p0_, p1_, (t));                                                                                                 \
        if constexpr (MLA) { partialSM2(p0_, p1_, mhat, negm, al_, (t) == 0); (void)mn_; } else { partialSM(p0_, p1_, m_reg, mn_, al_, SCALE); } \
        RESC(al_);                                                                                                            \
        finishSM(p0_, p1_, al_, l_reg, pa0, pa1, pa2, pa3); SBAR();                                                           \
        pv_tile<B, SK>(o, vb0, pa0, pa1, pa2, pa3, ACT(t));                                                                   \
        VMW(); __syncthreads(); } while (0)
    int t = 0;
    for (; t + 1 < NT; t += 2) { STEP(t, 0); STEP(t + 1, 1); }
    if (t < NT) { STEP(t, 0); }
    if (has_next) { DMA_TILE_P(nxt.K, nxt.V, nxt.Kpe, swa_jlo(nxt.P0, W) * KVBLK, 0); Q_LOADS(nxt); }
    if (hi == 0) li_l[r32] = l_reg; asm volatile("s_waitcnt lgkmcnt(0)" ::: "memory");
    if constexpr (LSEOUT) { if (hi == 0) cur.LSE[(size_t)(wid * QBLK + r32) * pt.lp] = m_reg * SCALE + __logf(l_reg); }
    float rli[16];
#pragma unroll
    for (int r = 0; r < 16; ++r) rli[r] = __builtin_amdgcn_rcpf(li_l[crow(r, hi)]);
    if constexpr (MERGE) { if (hi == 0) al_l[r32] = m_reg * SCALE + __logf(l_reg); asm volatile("s_waitcnt lgkmcnt(0)" ::: "memory"); }
    { ALDS char* stg = ldsa + (wid < 4 ? SHM_V + wid * 4096 : 2 * SHM_V + SHM_K + (wid - 4) * 4096);
      char* Ow = (char*)(cur.O + (size_t)(wid * QBLK) * pt.op);
#pragma unroll
      for (int p = 0; p < 2; ++p) {
#pragma unroll
        for (int r = 8 * p; r < 8 * p + 8; ++r) { const int orow = crow(r, hi) - 16 * p;
#pragma unroll
            for (int d0 = 0; d0 < 4; ++d0) { const float v = o[d0][r] * rli[r]; *(ALDS unsigned short*)(stg + orow * 256 + (d0 * 32 + r32) * 2) = (unsigned short)cvtpk(v, v); } }
        if constexpr (!MERGE) {
#pragma unroll
          for (int it = 0; it < 4; ++it) { const int r16 = it * 4 + (lane >> 4), row = 16 * p + r16, ch = lane & 15;
              const u32x4 w = *(ALDS const u32x4*)(stg + r16 * 256 + ch * 16); *(u32x4*)(Ow + (size_t)row * (size_t)(pt.op * 2) + ch * 16) = w; }
        } else {
          const char* O0 = (const char*)(cur.Om + (size_t)(wid * QBLK) * pt.op); const float* L0 = cur.Lm + (size_t)(wid * QBLK) * pt.lp;
#pragma unroll
          for (int it = 0; it < 4; ++it) { const int r16 = it * 4 + (lane >> 4), row = 16 * p + r16, ch = lane & 15;
              const float l2 = al_l[row], l0 = L0[(size_t)row * pt.lp], l1 = L0[(size_t)row * pt.lp + pt.ml], mx = fmaxf(l0, fmaxf(l1, l2));
              float e0 = __expf(l0 - mx), e1 = __expf(l1 - mx), e2 = __expf(l2 - mx); const float inv = 1.f / (e0 + e1 + e2); e0 *= inv; e1 *= inv; e2 *= inv;
              const size_t go = (size_t)row * (size_t)(pt.op * 2) + ch * 16;
              const u32x4 a0 = *(const u32x4*)(O0 + go), a1 = *(const u32x4*)(O0 + (size_t)pt.mo * 2 + go), a2 = *(ALDS const u32x4*)(stg + r16 * 256 + ch * 16); u32x4 w;
#pragma unroll
              for (int k = 0; k < 4; ++k) { const float lo = e0 * __builtin_bit_cast(float, a0[k] << 16) + e1 * __builtin_bit_cast(float, a1[k] << 16) + e2 * __builtin_bit_cast(float, a2[k] << 16);
                  const float hh = e0 * __builtin_bit_cast(float, a0[k] & 0xffff0000u) + e1 * __builtin_bit_cast(float, a1[k] & 0xffff0000u) + e2 * __builtin_bit_cast(float, a2[k] & 0xffff0000u);
                  w[k] = cvtpk(lo, hh); }
              *(u32x4*)(Ow + go) = w; }
        }
      } }
    if (!has_next) __syncthreads();
#undef RESC
#undef KBASE
#undef ACT
#undef MASKT
#undef STEP
}
#undef ROWP
#undef VMW
#undef DMA_TILE
#undef DMA_TILE_P
#undef Q_LOADS
template <bool MLA, bool SK, bool LSEOUT, bool MERGE, class Deal>
__device__ __forceinline__ void attn_phase(char* lds, const Deal& dl, int skv, int W, const Pitch& pt, const float SCALE, const int wave_) {
    BlockRef cur, nxt;
    if (!dl.get(0, cur)) return;
    bf16x8 qr[8], qpe[4]; bool first = true;
    for (int i = 0;; ++i) {
        const bool more = dl.get(i + 1, nxt);
        if (!more) nxt = cur;
        attn_block<MLA, SK, LSEOUT, MERGE>(cur, nxt, more, first, skv, W, lds, pt, SCALE, wave_, qr, qpe);
        if (!more) break;
        cur = nxt; first = false;
    }
}
#undef KSWZ
#undef SBAR
#undef ALDS
}

#ifndef LAS
#define LAS __attribute__((address_space(3)))
#endif
#define XB_TMO      128
#define XB_XCNT(j)  (256  + 64 * (j))
#define XB_XSUB(j)  (1280 + 64 * (j))
#define XB_XGEN(j)  (2304 + 64 * (j))
#define XB_TOP      3328
#define XB_TOPGEN   3392
#define XCD_BAR_WORDS 3456
#define XB_SPIN_CAP (1u << 18)

__device__ __forceinline__ unsigned xb_ld(unsigned* p)              { return __hip_atomic_load(p, __ATOMIC_RELAXED, __HIP_MEMORY_SCOPE_AGENT); }
__device__ __forceinline__ unsigned xb_add(unsigned* p, unsigned v) { return __hip_atomic_fetch_add(p, v, __ATOMIC_RELAXED, __HIP_MEMORY_SCOPE_AGENT); }
__device__ __forceinline__ unsigned xb_xcc_id() { return (unsigned)__builtin_amdgcn_s_getreg((3 << 11) | 20) & 0xFu; }
#define XB_SPIN(cond, bar) do { unsigned _sp = 0; while (cond) { __builtin_amdgcn_s_sleep(1); \
    if ((++_sp & 255u) == 0u) { if (xb_ld(&(bar)[XB_TMO])) break; if (_sp > XB_SPIN_CAP) { atomicAdd(&(bar)[XB_TMO], 1u); break; } } } } while (0)

struct XcdBarrier {
    unsigned* bar; unsigned x;
    volatile LAS unsigned* st;
};

__device__ __forceinline__ XcdBarrier xcd_barrier_post(unsigned* bar, volatile LAS unsigned* st, const bool is_t0) {
    XcdBarrier b; b.bar = bar; b.x = xb_xcc_id(); b.st = st;
    if (is_t0) (void)xb_add(&bar[XB_XCNT(b.x)], 1u);
    return b;
}
__device__ __forceinline__ void xcd_barrier_complete(unsigned* bar, unsigned x, unsigned& nloc, unsigned& nx) {
    const unsigned G = gridDim.x * gridDim.y * gridDim.z;
    unsigned sum, cnt, mine, sp = 0u;
    for (;;) {
        sum = 0u; cnt = 0u; mine = 0u;
#pragma unroll
        for (unsigned j = 0; j < 16; ++j) { const unsigned c = xb_ld(&bar[XB_XCNT(j)]); sum += c; cnt += (c > 0u) ? 1u : 0u; mine = (j == x) ? c : mine; }
        if (sum == G) break;
        __builtin_amdgcn_s_sleep(1);
        if ((++sp & 255u) == 0u) { if (xb_ld(&bar[XB_TMO])) break; if (sp > XB_SPIN_CAP) { atomicAdd(&bar[XB_TMO], 1u); break; } }
    }
    nloc = mine > 0u ? mine : 1u; nx = cnt > 0u ? cnt : 1u;
}

__device__ __forceinline__ void xcd_barrier(const XcdBarrier& b, const bool is_t0) {
    asm volatile("s_waitcnt vmcnt(0)" ::: "memory");
    __syncthreads();
    if (is_t0) {
        unsigned* bar = b.bar;
        __builtin_amdgcn_s_waitcnt(0);
        unsigned nloc = b.st[0], nx = b.st[1];
        if (nloc == 0u) { xcd_barrier_complete(bar, b.x, nloc, nx); b.st[0] = nloc; b.st[1] = nx; }
        const unsigned old = xb_add(&bar[XB_XSUB(b.x)], 1u);
        const unsigned gen = old / nloc;
        if (old + 1u == (gen + 1u) * nloc) {
            __builtin_amdgcn_fence(__ATOMIC_RELEASE, "agent");
            asm volatile("s_waitcnt vmcnt(0)" ::: "memory");
            const unsigned og = xb_add(&bar[XB_TOP], 1u);
            const unsigned tg = og / nx;
            if (og + 1u == (tg + 1u) * nx) xb_add(&bar[XB_TOPGEN], 1u);
            else XB_SPIN(xb_ld(&bar[XB_TOPGEN]) == tg, bar);
            __builtin_amdgcn_fence(__ATOMIC_ACQUIRE, "agent");
            xb_add(&bar[XB_XGEN(b.x)], 1u);
            asm volatile("s_waitcnt vmcnt(0)" ::: "memory");
        } else {
            XB_SPIN(xb_ld(&bar[XB_XGEN(b.x)]) == gen, bar);
            __builtin_amdgcn_fence(__ATOMIC_ACQUIRE, "agent");
            asm volatile("s_waitcnt vmcnt(0)" ::: "memory");
        }
    }
    __syncthreads();
}

constexpr int S_ = 16384, DM = 2048, FF = 5632, NQG = 6144;
constexpr float EPS = 1e-6f;
constexpr size_t MiB = 1u << 20;
constexpr size_t WS_RSKV = 0, WS_RSQ = 65536, WS_BAR = 131072, WS_SSQ = 262144;
constexpr size_t WS_COSA = 1 * MiB, WS_SINA = 2 * MiB, WS_COSB = 3 * MiB, WS_SINB = 5 * MiB;
constexpr size_t WS_LSE = 7 * MiB;
constexpr size_t WS_WQKV = 10 * MiB, WS_WOA = 82 * MiB, WS_WA = 90 * MiB, WS_WKVB = 95 * MiB, WS_WQB = 99 * MiB, WS_WOB = 102 * MiB;
constexpr size_t WS_WGU = 110 * MiB  , WS_WDN = 198 * MiB  ;
constexpr size_t WS_XN = 242 * MiB;
constexpr size_t WS_BIG = 306 * MiB;
constexpr size_t WS_END = 578 * MiB;
constexpr size_t BIG_QKVG = 0, BIG_OG2 = 192 * MiB, BIG_HB = 0, BIG_H1 = 64 * MiB, BIG_KV = 0, BIG_Q = 128 * MiB, BIG_C = 224 * MiB, BIG_CQ = 240 * MiB, BIG_KPE = 256 * MiB;
constexpr int RING_BYTES = 131072, LDS_TOTAL = 135168;
static_assert(att::LDS_BYTES <= LDS_TOTAL - 128, "attention scratch fits below the LDS control words");

typedef unsigned short bf16;
typedef unsigned v4u __attribute__((ext_vector_type(4)));
typedef float f32x4 __attribute__((ext_vector_type(4)));
#define LDS_WAIT() asm volatile("s_waitcnt lgkmcnt(0)" ::: "memory")
__device__ __forceinline__ unsigned f2bf(float f) { unsigned u = __builtin_bit_cast(unsigned, f); return (u + 0x7fffu + ((u >> 16) & 1u)) >> 16; }
__device__ __forceinline__ unsigned pk2(float lo, float hi) { return pg8::cvt_pk_bf16(lo, hi); }
__device__ __forceinline__ float bflo(unsigned w) { return __builtin_bit_cast(float, w << 16); }
__device__ __forceinline__ float bfhi(unsigned w) { return __builtin_bit_cast(float, w & 0xffff0000u); }
__device__ __forceinline__ float wave_sum(float v) {
#pragma unroll
    for (int o = 1; o < 64; o <<= 1) v += __shfl_xor(v, o);
    return v;
}
template <int MAP> __device__ __forceinline__ int dst_row(int n) {
    if constexpr (MAP == 1) { const int r = n % NQG, t = r / 2048, d = r & 127; if (t < 2 && d < 32) return n - d + 8 * ((d >> 2) & 3) + 4 * (d >> 4) + (d & 3); return n; }
    else if constexpr (MAP == 2) { if (n < 512) return n; const int d = n - 512; return 1024 + 32 * ((d >> 4) & 1) + 8 * ((d >> 2) & 3) + 4 * (d >> 5) + (d & 3); }
    else if constexpr (MAP == 3) { return 512 + n; }
    else if constexpr (MAP == 4) { const int h = n / 192, e = n % 192; if (e < 128) return h * 128 + e; const int d = e - 128; return 2048 + h * 64 + 32 * ((d >> 4) & 1) + 8 * ((d >> 2) & 3) + 4 * (d >> 5) + (d & 3); }
    else if constexpr (MAP == 5) { const int c = n < FF ? n : n - FF; return 256 * (c >> 7) + (n < FF ? 0 : 128) + (c & 127); }
    else return n;
}
template <int MAP> __device__ __forceinline__ void tr_item(const float* __restrict__ W, int K, int N, const float* __restrict__ gain, bf16* WT, LAS float* scr, int item, int lane) {
    const int nblk = N / 64, kb = item / nblk, nb = item % nblk, k0 = 64 * kb, n0 = 64 * nb;
    const int lr = lane >> 4, lc = (lane & 15) * 4;
    f32x4 v[16];
#pragma unroll
    for (int i = 0; i < 16; ++i) v[i] = *(const f32x4*)(W + (size_t)(k0 + 4 * i + lr) * N + n0 + lc);
    if (gain) {
#pragma unroll
        for (int i = 0; i < 16; ++i) v[i] = v[i] * gain[k0 + 4 * i + lr]; }
#pragma unroll
    for (int i = 0; i < 16; ++i) { LAS float* d = scr + (4 * i + lr) * 65 + lc; d[0] = v[i].x; d[1] = v[i].y; d[2] = v[i].z; d[3] = v[i].w; }
    LDS_WAIT(); asm volatile("" ::: "memory");
    const int c = lane & 7;
#pragma unroll
    for (int j = 0; j < 8; ++j) { const int n = (lane >> 3) + 8 * j; const LAS float* s = scr + (8 * c) * 65 + n;
        v4u o; o.x = pk2(s[0 * 65], s[1 * 65]); o.y = pk2(s[2 * 65], s[3 * 65]); o.z = pk2(s[4 * 65], s[5 * 65]); o.w = pk2(s[6 * 65], s[7 * 65]);
        *(v4u*)(WT + (size_t)dst_row<MAP>(n0 + n) * K + k0 + 8 * c) = o; }
    LDS_WAIT(); asm volatile("" ::: "memory");
}
__device__ __forceinline__ void rms_row_to_bf16(const float* xrow, bf16* orow, int lane) {
    const f32x4* xr = (const f32x4*)xrow + lane; f32x4 v[8]; float s = 0.f;
#pragma unroll
    for (int j = 0; j < 8; ++j) { v[j] = xr[64 * j]; s += (v[j].x * v[j].x + v[j].y * v[j].y) + (v[j].z * v[j].z + v[j].w * v[j].w); }
    const float rs = 1.0f / sqrtf(wave_sum(s) * (1.f / DM) + EPS);
    unsigned long long* o8 = (unsigned long long*)orow + lane;
#pragma unroll
    for (int j = 0; j < 8; ++j) o8[64 * j] = (unsigned long long)pk2(v[j].x * rs, v[j].y * rs) | ((unsigned long long)pk2(v[j].z * rs, v[j].w * rs) << 32);
}

__device__ __forceinline__ int opqv(int v) { asm volatile("" : "+v"(v)); return v; }
__device__ __forceinline__ int opaque(int v) { asm volatile("" : "+s"(v)); return v; }
struct Args { const float* in[16]; float* out; unsigned char* ws; };
#define KARG(k) (((void* const*)__builtin_amdgcn_kernarg_segment_ptr())[opaque(k)])
#define IN(k) ((const float*)KARG(k))
#define OUTP ((float*)KARG(16))
#define WSP ((unsigned char*)KARG(17))

struct DealDil {
    const bf16* QKV; bf16* OG; float* LSE; const bf16* OM; const float* LM; int dil, nqb, G, c;
    __device__ __forceinline__ bool get(int i, att::BlockRef& b) const {
        const int L = c + i * G; if (L >= 1024) return false;
        const int qb = L % nqb, t = L / nqb, h = t & 15, r = t >> 4; const size_t tok0 = (size_t)r + (size_t)dil * 256 * qb;
        b.Q = QKV + tok0 * NQG + h * 128; b.K = QKV + (size_t)r * NQG + 2048 + h * 128; b.V = QKV + (size_t)r * NQG + 4096 + h * 128;
        b.O = OG + tok0 * DM + h * 128; b.Qpe = nullptr; b.Kpe = nullptr; b.LSE = LSE + tok0 * 16 + h; b.Om = OM + tok0 * DM + h * 128; b.Lm = LM + tok0 * 16 + h; b.P0 = qb * 256; b.pad = 0; return true;
    }
};
struct DealMla {
    const bf16* Q; const bf16* KV; const bf16* KPE; bf16* O; int G, c;
    __device__ __forceinline__ bool get(int i, att::BlockRef& b) const {
        int h, y;
        if (G == 256) { if (i >= 4) return false; h = (c & 7) + 8 * (i >> 1); y = c >> 3; }
        else { const int item = c + (i >> 1) * G; if (item >= 512) return false; h = item >> 5; y = item & 31; }
        const int qb = (i & 1) ? y : 63 - y;
        b.Q = Q + (size_t)qb * 256 * 3072 + h * 128; b.Qpe = Q + (size_t)qb * 256 * 3072 + 2048 + h * 64; b.K = KV + h * 256; b.V = KV + h * 256 + 128; b.Kpe = KPE;
        b.O = O + (size_t)qb * 256 * DM + h * 128; b.LSE = nullptr; b.Om = nullptr; b.Lm = nullptr; b.P0 = qb * 256; b.pad = 0; return true;
    }
};

#ifndef PHMASK
#define PHMASK 0xffff
#endif
#define PH(k) ((PHMASK >> (k)) & 1)
#ifndef REP_P0
#define REP_P0 1
#endif
#ifndef REP_ATT0
#define REP_ATT0 1
#endif
#ifndef REP_MLA
#define REP_MLA 1
#endif
#ifndef REP_GU
#define REP_GU 1
#endif
#ifndef REP_QKV
#define REP_QKV 1
#endif
#ifndef REP_L1P
#define REP_L1P 1
#endif
#ifndef EXTRA_SYNCS
#define EXTRA_SYNCS 0
#endif
__global__ void __launch_bounds__(512, 2) mk_fwd(Args a) {
    extern __shared__ __attribute__((aligned(16))) unsigned char lds[];
    cg::grid_group grid = cg::this_grid();
    const int wave = __builtin_amdgcn_readfirstlane((int)threadIdx.x >> 6);
#define lane opqv(mk_lane())
#define tid (wave * 64 + opqv(mk_lane()))
    const int G = gridDim.x, bx = blockIdx.x, gw = bx * 8 + wave, NGW = G * 8;
    LAS unsigned char* ldsl = (LAS unsigned char*)lds;
    volatile LAS unsigned* MISC = (volatile LAS unsigned*)(ldsl + LDS_TOTAL - 128);
    { const int t_ = tid; if (t_ < 32) MISC[t_] = 0u;
      if (bx == 0) { unsigned* bw = (unsigned*)(WSP + WS_BAR); for (int i = t_; i < XCD_BAR_WORDS; i += 512) bw[i] = 0u; } }
    __syncthreads();
#define GBAR() do { XcdBarrier b_; b_.bar = (unsigned*)(WSP + WS_BAR); b_.x = xb_xcc_id(); b_.st = MISC + 8; xcd_barrier(b_, wave == 0 && mk_lane() == 0); } while (0)
    grid.sync();
    (void)xcd_barrier_post((unsigned*)(WSP + WS_BAR), MISC + 8, wave == 0 && mk_lane() == 0);

#if PH(0)
    for (int rep_ = 0; rep_ < REP_P0; ++rep_) {
        LAS float* scr = (LAS float*)(ldsl + wave * 16640); unsigned char* ws = WSP;
        bf16* Wqkv = (bf16*)(ws + WS_WQKV); bf16* Woa = (bf16*)(ws + WS_WOA); bf16* Wa = (bf16*)(ws + WS_WA); bf16* Wkvb = (bf16*)(ws + WS_WKVB);
        bf16* Wqb = (bf16*)(ws + WS_WQB); bf16* Wob = (bf16*)(ws + WS_WOB); bf16* Wgu = (bf16*)(ws + WS_WGU); bf16* Wdn = (bf16*)(ws + WS_WDN);
        float* cosA = (float*)(ws + WS_COSA); float* sinA = (float*)(ws + WS_SINA); float* cosB = (float*)(ws + WS_COSB); float* sinB = (float*)(ws + WS_SINB);
        constexpr int I_QKV = 32 * 288, I_O = 32 * 32, I_KVA = 32 * 9, I_QA = 32 * 8, I_KVB = 8 * 64, I_QB = 8 * 48, I_GU = 32 * 176, I_DN = 88 * 32;
        constexpr int NITEMS = I_QKV + 2 * I_O + I_KVA + I_QA + I_KVB + I_QB + 2 * I_GU + 2 * I_DN;
        for (int it = gw; it < NITEMS; it += NGW) {
            int r = it;
            if (r < I_QKV) { tr_item<1>(IN(3), DM, 18432, IN(1), Wqkv, scr, r, lane); continue; } r -= I_QKV;
            if (r < I_O) { tr_item<0>(IN(4), DM, DM, nullptr, Woa, scr, r, lane); continue; } r -= I_O;
            if (r < I_KVA) { tr_item<2>(IN(6), DM, 576, IN(5), Wa, scr, r, lane); continue; } r -= I_KVA;
            if (r < I_QA) { tr_item<3>(IN(9), DM, 512, IN(1) + DM, Wa, scr, r, lane); continue; } r -= I_QA;
            if (r < I_KVB) { tr_item<0>(IN(8), 512, 4096, IN(7), Wkvb, scr, r, lane); continue; } r -= I_KVB;
            if (r < I_QB) { tr_item<4>(IN(11), 512, 3072, IN(10), Wqb, scr, r, lane); continue; } r -= I_QB;
            if (r < I_O) { tr_item<0>(IN(12), DM, DM, nullptr, Wob, scr, r, lane); continue; } r -= I_O;
            if (r < I_GU) { tr_item<5>(IN(13), DM, 2 * FF, IN(2), Wgu, scr, r, lane); continue; } r -= I_GU;
            if (r < I_GU) { tr_item<5>(IN(13) + (size_t)DM * 2 * FF, DM, 2 * FF, IN(2) + DM, Wgu + (size_t)2 * FF * DM, scr, r, lane); continue; } r -= I_GU;
            if (r < I_DN) { tr_item<0>(IN(14), FF, DM, nullptr, Wdn, scr, r, lane); continue; } r -= I_DN;
            tr_item<0>(IN(14) + (size_t)FF * DM, FF, DM, nullptr, Wdn + (size_t)DM * FF, scr, r, lane);
        }
        { v4u z = {0u, 0u, 0u, 0u}; v4u* p = (v4u*)(Wa + (size_t)1088 * DM); const int n16 = 192 * DM * 2 / 16;
          for (int i = bx * 512 + tid; i < n16; i += G * 512) p[i] = z; }
        { float* q = (float*)(ws + WS_SSQ); for (int i = bx * 512 + tid; i < 6 * S_; i += G * 512) q[i] = 0.f; }
        { const int i0 = bx * 512 + tid; const float inv = powf(500000.0f, -(float)(2 * (i0 & 15)) / 32.0f);
          for (int i = i0; i < S_ * 16; i += G * 512) { const float ang = (float)(i >> 4) * inv; cosA[i] = cosf(ang); sinA[i] = sinf(ang); } }
        { const int i0 = bx * 512 + tid; const float inv = powf(500000.0f, -(float)(2 * (i0 & 31)) / 64.0f);
          for (int i = i0; i < S_ * 32; i += G * 512) { const float ang = (float)(i >> 5) * inv; cosB[i] = cosf(ang); sinB[i] = sinf(ang); } }
        { const float* x = IN(0); bf16* XN = (bf16*)(ws + WS_XN); for (int m = gw; m < S_; m += NGW) rms_row_to_bf16(x + (size_t)m * DM, XN + (size_t)m * DM, lane); }
    }
#endif
    GBAR();

    for (int g = 0; g < 3; ++g) {
#if PH(1)
        for (int rep_ = 0; rep_ < REP_QKV; ++rep_) {
            unsigned char* ws = WSP; bf16* QKVG = (bf16*)(ws + WS_BIG + BIG_QKVG);
            pg8::Gemm gm{(const bf16*)(ws + WS_XN), (const bf16*)(ws + WS_WQKV) + (size_t)g * NQG * DM, S_, NQG, opaque(DM)}; pg8::StaticOrder So; So.init(S_, NQG, G, bx);
            epi::EpiQKV E{QKVG, (const float*)(ws + WS_COSA), (const float*)(ws + WS_SINA)};
            pg8::gemm_phase<epi::EpiQKV, pg8::StaticOrder, true, true>(ldsl, gm, So, E, wave);
        }
#endif
        GBAR();
#if PH(2)
        for (int rep_ = 0; rep_ < REP_ATT0; ++rep_) {
            unsigned char* ws = WSP; bf16* QKVG = (bf16*)(ws + WS_BIG + BIG_QKVG);
            const int dil = g == 0 ? 1 : (g == 1 ? 4 : 16);
            bf16* OG = g == 2 ? (bf16*)(ws + WS_XN) : (bf16*)OUTP + (size_t)g * S_ * DM;
            DealDil dl{QKVG, OG, (float*)(ws + WS_LSE) + (size_t)g * S_ * 16, (const bf16*)OUTP, (const float*)(ws + WS_LSE), dil, (S_ / dil) / 256, G, bx};
            const att::Pitch pt{dil * NQG, dil * NQG, dil * NQG, dil * DM, dil * 16, S_ * DM, S_ * 16};
            if (g < 2) att::attn_phase<false, true, true, false, DealDil>((char*)lds, dl, S_ / dil, 129, pt, 0.08838834764831845f, wave);
            else att::attn_phase<false, true, false, true, DealDil>((char*)lds, dl, S_ / dil, 129, pt, 0.08838834764831845f, wave);
        }
#endif
        GBAR();
    }
#if PH(4)
    {
        unsigned char* ws = WSP;
        pg8::Gemm gm{(const bf16*)(ws + WS_XN), (const bf16*)(ws + WS_WOA), S_, DM, opaque(DM)}; pg8::StaticOrder So; So.init(S_, DM, G, bx);
        epi::EpiResid<true, false, true> E{IN(0), (bf16*)(ws + WS_BIG + BIG_HB), (float*)(ws + WS_SSQ)};
        pg8::gemm_phase<epi::EpiResid<true, false, true>, pg8::StaticOrder, true, true>(ldsl, gm, So, E, wave);
    }
#endif
    GBAR();
    for (int layer = 0; layer < 2; ++layer) {
        if (layer == 1) {
#define L1PTRS unsigned char* ws = WSP; unsigned char* BIG = ws + WS_BIG; bf16* XN = (bf16*)(ws + WS_XN); bf16* C = (bf16*)(BIG + BIG_C); bf16* CQ = (bf16*)(BIG + BIG_CQ); bf16* KPE = (bf16*)(BIG + BIG_KPE); bf16* KV = (bf16*)(BIG + BIG_KV); bf16* Q = (bf16*)(BIG + BIG_Q); const float* cosB = (const float*)(ws + WS_COSB); const float* sinB = (const float*)(ws + WS_SINB); float* rskv = (float*)(ws + WS_RSKV); float* rsq = (float*)(ws + WS_RSQ); (void)XN; (void)C; (void)CQ; (void)KPE; (void)KV; (void)Q; (void)cosB; (void)sinB; (void)rskv; (void)rsq;
#if PH(5)
            for (int rep_ = 0; rep_ < REP_L1P; ++rep_) {
                L1PTRS
                pg8::Gemm gm{(const bf16*)OUTP, (const bf16*)(ws + WS_WA), S_, 1280, opaque(DM)}; pg8::StaticOrder So; So.init(S_, 1280, G, bx);
                epi::EpiA E{C, CQ, KPE, cosB, sinB, (const float*)(ws + WS_SSQ) + S_, (float*)(ws + WS_SSQ) + 3 * S_, (float*)(ws + WS_SSQ) + 4 * S_};
                pg8::gemm_phase<epi::EpiA, pg8::StaticOrder, true, true>(ldsl, gm, So, E, wave);
            }
#endif
            GBAR();
#if PH(7)
            for (int rep_ = 0; rep_ < REP_L1P; ++rep_) {
                L1PTRS
                pg8::Gemm gm{C, (const bf16*)(ws + WS_WKVB), S_, 4096, opaque(512)}; pg8::StaticOrder So; So.init(S_, 4096, G, bx);
                epi::EpiRowScale E{KV, 4096, (const float*)(ws + WS_SSQ) + 3 * S_, 1 << 30, cosB, sinB, 1.0f};
                pg8::gemm_phase<epi::EpiRowScale, pg8::StaticOrder, true, true>(ldsl, gm, So, E, wave);
            }
            {
                L1PTRS
                pg8::Gemm gm{CQ, (const bf16*)(ws + WS_WQB), S_, 3072, opaque(512)}; pg8::StaticOrder So; So.init(S_, 3072, G, bx);
                epi::EpiRowScale E{Q, 3072, (const float*)(ws + WS_SSQ) + 4 * S_, 2048, cosB, sinB, 0.07216878364870323f * 1.4426950408889634f};
                pg8::gemm_phase<epi::EpiRowScale, pg8::StaticOrder, true, true>(ldsl, gm, So, E, wave);
            }
#endif
            GBAR();
#if PH(8)
            for (int rep_ = 0; rep_ < REP_MLA; ++rep_) {
                L1PTRS
                DealMla dl{Q, KV, KPE, XN, G, bx};
                const att::Pitch pt{3072, 4096, 4096, DM, 0, 0, 0};
                att::attn_phase<true, false, false, false, DealMla>((char*)lds, dl, S_, 1 << 24, pt, 0.07216878364870323f, wave);
            }
#endif
            GBAR();
#if PH(9)
            {
                L1PTRS
                pg8::Gemm gm{XN, (const bf16*)(ws + WS_WOB), S_, DM, opaque(DM)}; pg8::StaticOrder So; So.init(S_, DM, G, bx);
                epi::EpiResid<false, false, true> E{(const bf16*)OUTP, (bf16*)(BIG + BIG_HB), (float*)(ws + WS_SSQ) + 2 * S_};
                pg8::gemm_phase<epi::EpiResid<false, false, true>, pg8::StaticOrder, true, true>(ldsl, gm, So, E, wave);
            }
#endif
            GBAR();
        }
#if PH(10)
        for (int rep_ = 0; rep_ < REP_GU; ++rep_) {
            unsigned char* ws = WSP; bf16* H1 = (bf16*)(ws + WS_BIG + BIG_H1);
            pg8::Gemm gm{(const bf16*)(ws + WS_BIG + BIG_HB), (const bf16*)(ws + WS_WGU) + (size_t)layer * 2 * FF * DM, S_, 2 * FF, opaque(DM)}; pg8::StaticOrder So; So.init(S_, 2 * FF, G, bx);
            epi::EpiSwiGLU E{H1, (const float*)(ws + WS_SSQ) + (size_t)(2 * layer) * S_};
            pg8::gemm_phase<epi::EpiSwiGLU, pg8::StaticOrder, true, true>(ldsl, gm, So, E, wave);
        }
#endif
        GBAR();
#if PH(11)
        {
            unsigned char* ws = WSP; bf16* H1 = (bf16*)(ws + WS_BIG + BIG_H1); float* out = OUTP;
            pg8::Gemm gm{H1, (const bf16*)(ws + WS_WDN) + (size_t)layer * DM * FF, S_, DM, opaque(FF)}; pg8::StaticOrder So; So.init(S_, DM, G, bx);
            const bf16* hb = (const bf16*)(ws + WS_BIG + BIG_HB);
            if (layer == 0) { epi::EpiResid<false, false, true> E{hb, (bf16*)out, (float*)(ws + WS_SSQ) + S_};
                pg8::gemm_phase<epi::EpiResid<false, false, true>, pg8::StaticOrder, true, true>(ldsl, gm, So, E, wave); }
            else { epi::EpiResid<false, false, true> E{hb, (bf16*)(ws + WS_XN), (float*)(ws + WS_SSQ) + 5 * S_};
                pg8::gemm_phase<epi::EpiResid<false, false, true>, pg8::StaticOrder, true, true>(ldsl, gm, So, E, wave); }
        }
#endif
        GBAR();
    }
    for (int rep_ = 0; rep_ < EXTRA_SYNCS; ++rep_) GBAR();
#if PH(12)
    {
        const float* gn = IN(15); float* out = OUTP; const bf16* hx = (const bf16*)(WSP + WS_XN); const float* sq = (const float*)(WSP + WS_SSQ) + 5 * S_;
        for (int m = gw; m < S_; m += NGW) { const int ln = lane; const float rs = 1.0f / sqrtf(sq[m + opqv(0)] * (1.f / DM) + EPS);
#pragma unroll
            for (int j = 0; j < 4; ++j) { const int c8 = (j * 64 + ln) * 8; const v4u w = *(const v4u*)(hx + (size_t)m * DM + c8);
                const f32x4 g0 = *(const f32x4*)(gn + c8), g1 = *(const f32x4*)(gn + c8 + 4);
                f32x4 o0 = {bflo(w[0]), bfhi(w[0]), bflo(w[1]), bfhi(w[1])}, o1 = {bflo(w[2]), bfhi(w[2]), bflo(w[3]), bfhi(w[3])};
                *(f32x4*)(out + (size_t)m * DM + c8) = o0 * rs * g0; *(f32x4*)(out + (size_t)m * DM + c8 + 4) = o1 * rs * g1; } }
    }
#endif
#undef GBAR
#undef lane
#undef tid
}

extern "C" void kernel_launch(void* const* d_in, const int* in_sizes, int n_in, void* d_out, int out_size, void* d_ws, size_t ws_size, hipStream_t stream) {
    static int grid = 0;
    if (grid == 0) {
        if (n_in != 16 || in_sizes[0] != S_ * DM || out_size != S_ * DM || ws_size < WS_END) { fprintf(stderr, "kernel_launch: unexpected shapes (n_in %d, ws %zu, need %zu)\n", n_in, ws_size, (size_t)WS_END); grid = -1; return; }
        int dev = 0, cus = 0, per_cu = 0;
        if (hipGetDevice(&dev) != hipSuccess || hipDeviceGetAttribute(&cus, hipDeviceAttributeMultiprocessorCount, dev) != hipSuccess) { grid = -1; return; }
        if (hipFuncSetAttribute((const void*)mk_fwd, hipFuncAttributeMaxDynamicSharedMemorySize, LDS_TOTAL) != hipSuccess) { fprintf(stderr, "kernel_launch: hipFuncSetAttribute failed\n"); grid = -1; return; }
        if (hipOccupancyMaxActiveBlocksPerMultiprocessor(&per_cu, (const void*)mk_fwd, 512, LDS_TOTAL) != hipSuccess || per_cu < 1) { fprintf(stderr, "kernel_launch: occupancy query says %d\n", per_cu); per_cu = 1; }
        (void)hipGetLastError();
        grid = cus;
    }
    if (grid < 0) return;
    Args a{};
    for (int i = 0; i < 16; ++i) a.in[i] = (const float*)d_in[i];
    a.out = (float*)d_out; a.ws = (unsigned char*)d_ws;
    void* args[] = {&a};
    hipError_t e = hipLaunchCooperativeKernel((const void*)mk_fwd, dim3(grid), dim3(512), args, LDS_TOTAL, stream);
    if (e != hipSuccess) fprintf(stderr, "kernel_launch: cooperative launch failed: %s (grid %d)\n", hipGetErrorString(e), grid);
}
```
